# Optimizing an MI355X kernel written in HIP

```python
import math
import jax, jax.numpy as jnp
from jax import lax
import numpy as np

D_MODEL = 4096
BATCH = 4
SEQ = 4096
DEPTH = 2

HEAD_DIM = 128
POOL_WINDOWS = (2, 4, 8, 16)
POOL_GROUPS = 4
POOL_GROUP_DIM = D_MODEL // 16
POOL_DIM = POOL_GROUPS * POOL_GROUP_DIM
ATTN_DIM = (D_MODEL - POOL_DIM) // 2
FOX_HEADS = ATTN_DIM // HEAD_DIM
GDN_DIM = D_MODEL - POOL_DIM - ATTN_DIM
GDN_HEADS = GDN_DIM // HEAD_DIM
MIX_DIM = POOL_DIM + ATTN_DIM + GDN_DIM
Q_BLOCK = 128
GDN_CHUNK = 64
GDN_CONV = 4
FFN_DIM = 11008
FFN_CONV = 3
EPS = 1e-6
IN_SIZES = (POOL_DIM, 3 * ATTN_DIM, FOX_HEADS, 3 * GDN_DIM, GDN_DIM, GDN_HEADS, GDN_HEADS)
IN_DIM = sum(IN_SIZES)

kernel_name = "hybrid_pool_fox_gdn_convffn"


def rms_norm(x, gain):
    xf = x.astype(jnp.float32)
    xf = xf * lax.rsqrt(jnp.mean(xf * xf, axis=-1, keepdims=True) + EPS)
    return (xf * gain.astype(jnp.float32)).astype(x.dtype)


def l2_normalize(x):
    return x * lax.rsqrt(jnp.sum(x * x, axis=-1, keepdims=True) + EPS)


def causal_depthwise_conv(x, w):
    k_width = w.shape[0]
    t = x.shape[1]
    xp = jnp.pad(x, ((0, 0), (k_width - 1, 0), (0, 0)))
    return sum(xp[:, i:i + t] * w[i] for i in range(k_width))


def split_columns(h):
    outs = []
    start = 0
    for size in IN_SIZES:
        outs.append(h[..., start:start + size])
        start += size
    return outs


def multiscale_pool_mixer(v, w_group, scale):
    b, t, _ = v.shape
    vf = v.astype(jnp.float32).reshape(b, t, POOL_GROUPS, POOL_GROUP_DIM)
    cs = jnp.cumsum(vf, axis=1)
    pos = jnp.arange(1, t + 1, dtype=jnp.float32)
    outs = []
    for gi, win in enumerate(POOL_WINDOWS):
        c = cs[:, :, gi]
        shifted = jnp.pad(c, ((0, 0), (win, 0), (0, 0)))[:, :t]
        mean = (c - shifted) / jnp.minimum(pos, float(win))[None, :, None]
        outs.append(mean - vf[:, :, gi])
    pooled = jnp.stack(outs, axis=2).astype(v.dtype)
    y = jnp.einsum('btgc,gce->btge', pooled, w_group).reshape(b, t, POOL_DIM)
    return y * scale


def forgetting_attention(q, k, v, log_f):
    b, t, h, d = q.shape
    scale = 1.0 / math.sqrt(d)
    cum = jnp.transpose(jnp.cumsum(log_f, axis=1), (0, 2, 1))
    outs = []
    for blk in range(t // Q_BLOCK):
        t0, t1 = blk * Q_BLOCK, (blk + 1) * Q_BLOCK
        qb, kb, vb = q[:, t0:t1], k[:, :t1], v[:, :t1]
        s = jnp.einsum('bqhd,bkhd->bhqk', qb, kb).astype(jnp.float32) * scale
        s = s + (cum[:, :, t0:t1, None] - cum[:, :, None, :t1])
        mask = jnp.arange(t0, t1)[:, None] >= jnp.arange(t1)[None, :]
        s = jnp.where(mask, s, -jnp.inf)
        p = jax.nn.softmax(s, axis=-1).astype(v.dtype)
        outs.append(jnp.einsum('bhqk,bkhd->bqhd', p, vb))
    return jnp.concatenate(outs, axis=1)


def gated_delta_rule(q, k, v, g, beta):
    b, t, h, d = q.shape
    n = t // GDN_CHUNK
    q = l2_normalize(q) * (d ** -0.5)
    k = l2_normalize(k)

    def chunks(a):
        a = a.reshape((b, n, GDN_CHUNK, h) + a.shape[3:])
        return jnp.moveaxis(a, 3, 1)

    q, k, v = chunks(q), chunks(k), chunks(v)
    beta = chunks(beta)
    g = jnp.cumsum(chunks(g), axis=-1)
    idx = jnp.arange(GDN_CHUNK)
    causal = idx[:, None] >= idx[None, :]
    strict = idx[:, None] > idx[None, :]
    decay = jnp.exp(jnp.where(causal, g[..., :, None] - g[..., None, :], -jnp.inf))
    k_beta = k * beta[..., None]
    a_mat = jnp.where(strict, jnp.einsum('bhncd,bhnsd->bhncs', k_beta, k) * decay, 0.0)
    rhs = jnp.concatenate([v * beta[..., None], k_beta * jnp.exp(g)[..., None]], axis=-1)
    eye = jnp.eye(GDN_CHUNK, dtype=jnp.float32)
    sol = lax.linalg.triangular_solve(a_mat + eye, rhs, left_side=True, lower=True,
                                      unit_diagonal=True)
    u, w = sol[..., :d], sol[..., d:]
    intra = jnp.where(causal, jnp.einsum('bhncd,bhnsd->bhncs', q, k) * decay, 0.0)
    g_last = g[..., -1]
    k_dec = k * jnp.exp(g_last[..., None] - g)[..., None]
    q_dec = q * jnp.exp(g)[..., None]

    def step(state, inp):
        q_n, k_n, u_n, w_n, intra_n, gl_n = inp
        v_new = u_n - jnp.einsum('bhcd,bhde->bhce', w_n, state)
        o = jnp.einsum('bhcd,bhde->bhce', q_n, state) + jnp.einsum('bhcs,bhse->bhce', intra_n, v_new)
        state = state * jnp.exp(gl_n)[..., None, None] + jnp.einsum('bhcd,bhce->bhde', k_n, v_new)
        return state, o

    xs = tuple(jnp.moveaxis(a, 2, 0) for a in (q_dec, k_dec, u, w, intra, g_last))
    state0 = jnp.zeros((b, h, d, v.shape[-1]), jnp.float32)
    _, o = lax.scan(step, state0, xs)
    return jnp.transpose(o, (1, 0, 3, 2, 4)).reshape(b, t, h, -1)


def setup_inputs(seed: int = 0) -> dict:
    key = jax.random.key(seed)
    ks = jax.random.split(key, 16)
    f32 = jnp.float32
    x = jax.random.normal(ks[0], (BATCH, SEQ, D_MODEL), f32)
    norm_mix_gain = 1.0 + 0.05 * jax.random.normal(ks[1], (DEPTH, D_MODEL), f32)
    w_in = jax.random.normal(ks[2], (DEPTH, D_MODEL, IN_DIM), f32) * D_MODEL ** -0.5
    pool_w = jax.random.normal(ks[3], (DEPTH, POOL_GROUPS, POOL_GROUP_DIM, POOL_GROUP_DIM), f32) * POOL_GROUP_DIM ** -0.5
    pool_scale = 1.0 + 0.1 * jax.random.normal(ks[4], (DEPTH, POOL_DIM), f32)
    fox_f_bias = 2.0 + 0.5 * jax.random.normal(ks[5], (DEPTH, FOX_HEADS), f32)
    gdn_conv_w = jax.random.normal(ks[6], (DEPTH, GDN_CONV, 3 * GDN_DIM), f32) * GDN_CONV ** -0.5
    gdn_A_log = jnp.log(jax.random.uniform(ks[7], (DEPTH, GDN_HEADS), f32, 1.0, 16.0))
    dt = jnp.exp(jax.random.uniform(ks[8], (DEPTH, GDN_HEADS), f32, math.log(1e-3), math.log(1e-1)))
    gdn_dt_bias = dt + jnp.log(-jnp.expm1(-dt))
    gdn_norm_gain = 1.0 + 0.05 * jax.random.normal(ks[9], (DEPTH, HEAD_DIM), f32)
    w_o = jax.random.normal(ks[10], (DEPTH, MIX_DIM, D_MODEL), f32) * MIX_DIM ** -0.5
    norm_ffn_gain = 1.0 + 0.05 * jax.random.normal(ks[11], (DEPTH, D_MODEL), f32)
    w_up = jax.random.normal(ks[12], (DEPTH, D_MODEL, 2 * FFN_DIM), f32) * D_MODEL ** -0.5
    ffn_conv_w = jax.random.normal(ks[13], (DEPTH, FFN_CONV, 2 * FFN_DIM), f32) * FFN_CONV ** -0.5
    w_down = jax.random.normal(ks[14], (DEPTH, FFN_DIM, D_MODEL), f32) * FFN_DIM ** -0.5
    final_norm_gain = 1.0 + 0.05 * jax.random.normal(ks[15], (D_MODEL,), f32)
    return {"x": x, "norm_mix_gain": norm_mix_gain, "w_in": w_in, "pool_w": pool_w,
            "pool_scale": pool_scale, "fox_f_bias": fox_f_bias, "gdn_conv_w": gdn_conv_w,
            "gdn_A_log": gdn_A_log, "gdn_dt_bias": gdn_dt_bias, "gdn_norm_gain": gdn_norm_gain,
            "w_o": w_o, "norm_ffn_gain": norm_ffn_gain, "w_up": w_up, "ffn_conv_w": ffn_conv_w,
            "w_down": w_down, "final_norm_gain": final_norm_gain}


def reference(x, norm_mix_gain, w_in, pool_w, pool_scale, fox_f_bias, gdn_conv_w, gdn_A_log,
              gdn_dt_bias, gdn_norm_gain, w_o, norm_ffn_gain, w_up, ffn_conv_w, w_down,
              final_norm_gain):
    b, t, _ = x.shape
    f32 = jnp.float32
    for l in range(DEPTH):
        h = rms_norm(x, norm_mix_gain[l])
        proj = h @ w_in[l]
        pool_in, fox_qkv, fox_f, gdn_qkv, gdn_z, gdn_b, gdn_a = split_columns(proj)

        y_pool = multiscale_pool_mixer(pool_in, pool_w[l], pool_scale[l])

        fq, fk, fv = (a.reshape(b, t, FOX_HEADS, HEAD_DIM) for a in jnp.split(fox_qkv, 3, axis=-1))
        log_f = jax.nn.log_sigmoid(fox_f.astype(f32) + fox_f_bias[l].astype(f32))
        y_fox = forgetting_attention(fq, fk, fv, log_f).reshape(b, t, ATTN_DIM)

        gqkv = jax.nn.silu(causal_depthwise_conv(gdn_qkv, gdn_conv_w[l]))
        gq, gk, gv = (a.reshape(b, t, GDN_HEADS, HEAD_DIM).astype(f32) for a in jnp.split(gqkv, 3, axis=-1))
        beta = jax.nn.sigmoid(gdn_b.astype(f32))
        g = -jnp.exp(gdn_A_log[l].astype(f32)) * jax.nn.softplus(gdn_a.astype(f32) + gdn_dt_bias[l].astype(f32))
        o = gated_delta_rule(gq, gk, gv, g, beta)
        z = gdn_z.reshape(b, t, GDN_HEADS, HEAD_DIM).astype(f32)
        o = rms_norm(o, gdn_norm_gain[l]) * jax.nn.silu(z)
        y_gdn = o.reshape(b, t, GDN_DIM).astype(x.dtype)

        mix = jnp.concatenate([y_pool.astype(x.dtype), y_fox.astype(x.dtype), y_gdn], axis=-1)
        x = x + mix @ w_o[l]

        h = rms_norm(x, norm_ffn_gain[l])
        u = causal_depthwise_conv(h @ w_up[l], ffn_conv_w[l])
        gate, up = jnp.split(u, 2, axis=-1)
        x = x + (jax.nn.silu(gate) * up) @ w_down[l]
    return rms_norm(x, final_norm_gain)
```

```cpp
#include <hip/hip_runtime.h>
#include <cstdio>
#include <cstdint>
#include <cstddef>
__device__ __forceinline__ int tid_local() { int t; asm volatile("v_mov_b32 %0, %1" : "=v"(t) : "v"(threadIdx.x)); return t; }
namespace pg8 {
#define PG8_LAS __attribute__((address_space(3)))
typedef unsigned short bf16_t;
typedef short bf16x8 __attribute__((ext_vector_type(8)));
typedef float f32x4 __attribute__((ext_vector_type(4)));
typedef unsigned u32x4 __attribute__((ext_vector_type(4)));
constexpr int BM = 256, BK = 64, HALF = 128, HTB = HALF * BK * 2  , STAGE_BYTES = 8 * HTB, NXCD = 8, WGM = 8;

__host__ __device__ __forceinline__ int lds_byte(int r, int c) { const int st = (r >> 4) * 2 + (c >> 5), rr = r & 15, cc = c & 31, ob = rr * 64 + cc * 2; return st * 1024 + (ob ^ (((ob >> 9) & 1) << 5)); }
__host__ __device__ __forceinline__ void stage_rc(int b, int& R, int& C) { const int st = b / 1024, sb = b % 1024, swz = sb ^ (((sb >> 9) & 1) << 5); R = (st >> 1) * 16 + swz / 64; C = (st & 1) * 32 + (swz % 64) / 2; }
__host__ __device__ __forceinline__ int perm32(int rho) { const int n = rho >> 4, i = rho & 15; return 8 * (i >> 2) + 4 * n + (i & 3); }

struct Unit { int pm, pn; };
struct Gemm { const bf16_t* A; const bf16_t* Bt; int M, N, K; };

struct StaticOrder {
    int nM, nN, nwg, G, c;
    __host__ __device__ void init(int M, int N, int G_, int c_) { nM = M / BM; nN = N / BM; nwg = nM * nN; G = G_; c = c_; }
    __host__ __device__ bool next(int i, Unit& u) const {
        const long L = (long)i * G + c; if (L >= nwg) return false;
        int wgid = (int)L; { const int q = nwg / NXCD, r = nwg % NXCD, xcd = wgid % NXCD, off = wgid / NXCD; wgid = (xcd < r ? xcd * (q + 1) : r * (q + 1) + (xcd - r) * q) + off; }
        const int nig = WGM * nN, gid = wgid / nig, fm = gid * WGM, gsz = (nM - fm) < WGM ? (nM - fm) : WGM;
        u.pm = fm + ((wgid % nig) % gsz); u.pn = (wgid % nig) / gsz; return true;
    }
    __device__ __forceinline__ void a_ready(const Unit&) const {}
    __device__ __forceinline__ void done(const Unit&) const {}
};

typedef float f32x2_t __attribute__((ext_vector_type(2))); typedef __bf16 bf16x2_t __attribute__((ext_vector_type(2)));
__device__ __forceinline__ unsigned cvt_pk_bf16(float lo, float hi) { f32x2_t v = {lo, hi}; bf16x2_t b = __builtin_convertvector(v, bf16x2_t); return __builtin_bit_cast(unsigned, b); }
typedef float f32x2 __attribute__((ext_vector_type(2)));
struct EpiProj {
    static constexpr bool PERM = true, AFTER_DRAIN = false;
    bf16_t* O; int ldc; float* small; int pn_small;
    __device__ __forceinline__ void operator()(const f32x4 (&acc)[2][2][4][2], const Unit& u, int wr, int wc, int fr, int fq) const {
        const int row0 = u.pm * BM + wr * 64 + fr, col0 = u.pn * BM + wc * 32 + 8 * fq;
        if (u.pn == pn_small) {
            if (wc < 2) {
#pragma unroll
                for (int ai = 0; ai < 2; ++ai)
#pragma unroll
                    for (int m = 0; m < 4; ++m) { float* sp = small + (size_t)(row0 + ai * HALF + m * 16) * 64 + wc * 32 + 8 * fq;
                        *(f32x4*)sp = acc[ai][0][m][0]; *(f32x4*)(sp + 4) = acc[ai][0][m][1]; }
            }
            return;
        }
#pragma unroll
        for (int ai = 0; ai < 2; ++ai)
#pragma unroll
            for (int m = 0; m < 4; ++m) { bf16_t* rowp = O + (size_t)(row0 + ai * HALF + m * 16) * ldc + col0;
#pragma unroll
                for (int bj = 0; bj < 2; ++bj) { const f32x4 v0 = acc[ai][bj][m][0], v1 = acc[ai][bj][m][1];
                    u32x4 w; w.x = cvt_pk_bf16(v0[0], v0[1]); w.y = cvt_pk_bf16(v0[2], v0[3]); w.z = cvt_pk_bf16(v1[0], v1[1]); w.w = cvt_pk_bf16(v1[2], v1[3]);
                    *(u32x4*)(rowp + bj * HALF) = w; } }
    }
};
struct EpiBf {
    static constexpr bool PERM = true, AFTER_DRAIN = false;
    bf16_t* O; int ldc;
    __device__ __forceinline__ void operator()(const f32x4 (&acc)[2][2][4][2], const Unit& u, int wr, int wc, int fr, int fq) const {
        const int row0 = u.pm * BM + wr * 64 + fr, col0 = u.pn * BM + wc * 32 + 8 * fq;
#pragma unroll
        for (int ai = 0; ai < 2; ++ai)
#pragma unroll
            for (int m = 0; m < 4; ++m) { bf16_t* rowp = O + (size_t)(row0 + ai * HALF + m * 16) * ldc + col0;
#pragma unroll
                for (int bj = 0; bj < 2; ++bj) { const f32x4 v0 = acc[ai][bj][m][0], v1 = acc[ai][bj][m][1];
                    u32x4 w; w.x = cvt_pk_bf16(v0[0], v0[1]); w.y = cvt_pk_bf16(v0[2], v0[3]); w.z = cvt_pk_bf16(v1[0], v1[1]); w.w = cvt_pk_bf16(v1[2], v1[3]);
                    *(u32x4*)(rowp + bj * HALF) = w; } }
    }
};
struct EpiResid {
    static constexpr bool PERM = false, AFTER_DRAIN = false;
    const float* base; float* out; int ldc;
    __device__ __forceinline__ void operator()(const f32x4 (&acc)[2][2][4][2], const Unit& u, int wr, int wc, int fr, int fq) const {
        const int col0 = u.pn * BM + wc * 32 + 4 * fq;
#pragma unroll
        for (int ai = 0; ai < 2; ++ai)
#pragma unroll
            for (int m = 0; m < 4; ++m) { const size_t off = (size_t)(u.pm * BM + ai * HALF + wr * 64 + m * 16 + fr) * ldc + col0;
#pragma unroll
                for (int bj = 0; bj < 2; ++bj)
#pragma unroll
                    for (int n = 0; n < 2; ++n) { const f32x4 bs = *(const f32x4*)(base + off + bj * HALF + n * 16); *(f32x4*)(out + off + bj * HALF + n * 16) = bs + acc[ai][bj][m][n]; } }
    }
};
template <class Epi, class Sched, bool ALIGN_EPI = false, bool SP2 = false>
__device__ __forceinline__ void gemm_phase(PG8_LAS unsigned char* lds, const Gemm g, const Sched& S, const Epi& E) {
    const int tid = tid_local(), wid = __builtin_amdgcn_readfirstlane(tid >> 6), lane = tid & 63, wr = wid >> 2, wc = wid & 3, fr = lane & 15, fq = lane >> 4;
    const int K = g.K, nt = K / BK;
    unsigned voffA[2], voffB[2];
#pragma unroll
    for (int i = 0; i < 2; ++i) { int R, C; stage_rc(tid * 16 + i * 8192, R, C); const int Rb = Epi::PERM ? ((R & ~31) + perm32(R & 31)) : R;
        voffA[i] = (unsigned)(R * K + C) * 2u; voffB[i] = (unsigned)(Rb * K + C) * 2u; }
    const size_t kstep = (size_t)(BK * 2);
    const size_t hstep = (size_t)HALF * K * 2;
    const size_t tstep = 2 * hstep;
    const unsigned ldsw = (unsigned)wid * 1024u;
    const int aoff = lds_byte(wr * 64 + fr, fq * 8), boff = lds_byte(wc * 32 + fr, fq * 8);
#define PG8_SA(b, h) (((b) * 2 + (h)) * HTB)
#define PG8_SB(b, h) ((4 + (b) * 2 + (h)) * HTB)
#define PG8_STAGE(bufoff, gbase, voff) do { _Pragma("unroll") for (int _i = 0; _i < 2; ++_i) \
        __builtin_amdgcn_global_load_lds((const unsigned*)((const char*)(gbase) + (voff)[_i]), (PG8_LAS unsigned*)(lds + (bufoff) + ldsw + _i * 8192), 16, 0, 0); } while (0)
#define PG8_LDA(dst, b, h) do { _Pragma("unroll") for (int m = 0; m < 4; ++m) _Pragma("unroll") for (int k = 0; k < 2; ++k) dst[m][k] = *(const PG8_LAS bf16x8*)(lds + PG8_SA(b, h) + aoff + m * 2048 + k * 1024); } while (0)
#define PG8_LDB(dst, b, h) do { _Pragma("unroll") for (int n = 0; n < 2; ++n) _Pragma("unroll") for (int k = 0; k < 2; ++k) dst[n][k] = *(const PG8_LAS bf16x8*)(lds + PG8_SB(b, h) + boff + n * 2048 + k * 1024); } while (0)
#define PG8_MMA(ai, bj, At, Bt) do { __builtin_amdgcn_s_setprio(1); _Pragma("unroll") for (int m = 0; m < 4; ++m) _Pragma("unroll") for (int n = 0; n < 2; ++n) _Pragma("unroll") for (int k = 0; k < 2; ++k) \
        acc[ai][bj][m][n] = __builtin_amdgcn_mfma_f32_16x16x32_bf16(Bt[n][k], At[m][k], acc[ai][bj][m][n], 0, 0, 0); __builtin_amdgcn_s_setprio(0); } while (0)
#define PG8_WAIT_V(n) asm volatile("s_waitcnt vmcnt(" #n ")" ::: "memory")
#define PG8_WAIT_L(n) asm volatile("s_waitcnt lgkmcnt(" #n ")" ::: "memory")
#define PG8_BAR __builtin_amdgcn_s_barrier()
#define PG8_SCHED __builtin_amdgcn_sched_barrier(0)
    Unit cur, nxt; int ui = 0;
    if (!S.next(0, cur)) return;
    f32x4 acc[2][2][4][2];
#pragma unroll
    for (int a = 0; a < 2; ++a)
#pragma unroll
        for (int b = 0; b < 2; ++b)
#pragma unroll
            for (int m = 0; m < 4; ++m)
#pragma unroll
                for (int n = 0; n < 2; ++n) acc[a][b][m][n] = (f32x4){0.f, 0.f, 0.f, 0.f};
    bf16x8 At[4][2], B0[2][2], B1[2][2];
    const char* cA = (const char*)g.A + (size_t)cur.pm * tstep; const char* cB = (const char*)g.Bt + (size_t)cur.pn * tstep;
    S.a_ready(cur);
    if constexpr (SP2) {
        PG8_STAGE(PG8_SB(0, 0), cB, voffB); PG8_STAGE(PG8_SB(0, 1), cB + hstep, voffB); PG8_STAGE(PG8_SA(0, 0), cA, voffA); PG8_STAGE(PG8_SA(0, 1), cA + hstep, voffA);
        if (wr == 1) PG8_BAR;
        PG8_WAIT_V(2); PG8_BAR;
        PG8_STAGE(PG8_SB(1, 0), cB + kstep, voffB); PG8_STAGE(PG8_SA(1, 0), cA + kstep, voffA); PG8_STAGE(PG8_SB(1, 1), cB + hstep + kstep, voffB);
        PG8_WAIT_V(6); PG8_BAR;
    } else {
        PG8_STAGE(PG8_SB(0, 0), cB, voffB); PG8_STAGE(PG8_SA(0, 0), cA, voffA); PG8_STAGE(PG8_SB(0, 1), cB + hstep, voffB); PG8_STAGE(PG8_SA(0, 1), cA + hstep, voffA);
        if (wr == 1) PG8_BAR;
        PG8_WAIT_V(4); PG8_BAR;
        PG8_STAGE(PG8_SB(1, 0), cB + kstep, voffB); PG8_STAGE(PG8_SA(1, 0), cA + kstep, voffA); PG8_STAGE(PG8_SB(1, 1), cB + hstep + kstep, voffB);
        PG8_WAIT_V(6); PG8_BAR;
    }
    for (;;) {
        const bool has_next = S.next(ui + 1, nxt);
        const char* nA = has_next ? (const char*)g.A + (size_t)nxt.pm * tstep : cA; const char* nB = has_next ? (const char*)g.Bt + (size_t)nxt.pn * tstep : cB;
        for (int t = 0; t < nt; t += 2) {
            const bool last = (t == nt - 2);
            const char* a1 = cA + (size_t)(t + 1) * kstep;
            const char* a2 = last ? nA : cA + (size_t)(t + 2) * kstep; const char* b2 = last ? nB : cB + (size_t)(t + 2) * kstep;
            const char* a3 = a2 + kstep; const char* b3 = b2 + kstep;
            if (last && has_next) S.a_ready(nxt);
            if constexpr (SP2) {
            PG8_LDB(B0, 0, 0); PG8_LDB(B1, 0, 1); PG8_SCHED; PG8_LDA(At, 0, 0); PG8_STAGE(PG8_SA(1, 1), a1 + hstep, voffA);
            PG8_WAIT_V(8); PG8_WAIT_L(0); PG8_BAR; PG8_MMA(0, 0, At, B0); PG8_MMA(0, 1, At, B1); PG8_BAR; PG8_SCHED;
            PG8_LDA(At, 0, 1); PG8_STAGE(PG8_SB(0, 0), b2, voffB); PG8_STAGE(PG8_SB(0, 1), b2 + hstep, voffB); PG8_STAGE(PG8_SA(0, 0), a2, voffA);
            PG8_WAIT_V(8); PG8_WAIT_L(0); PG8_BAR; PG8_MMA(1, 0, At, B0); PG8_MMA(1, 1, At, B1); PG8_BAR; PG8_SCHED;
            PG8_LDB(B0, 1, 0); PG8_LDB(B1, 1, 1); PG8_SCHED; PG8_LDA(At, 1, 0); PG8_STAGE(PG8_SA(0, 1), a2 + hstep, voffA);
            PG8_WAIT_V(8); PG8_WAIT_L(0); PG8_BAR; PG8_MMA(0, 0, At, B0); PG8_MMA(0, 1, At, B1); PG8_BAR; PG8_SCHED;
            PG8_LDA(At, 1, 1); PG8_STAGE(PG8_SB(1, 0), b3, voffB); PG8_STAGE(PG8_SB(1, 1), b3 + hstep, voffB); PG8_STAGE(PG8_SA(1, 0), a3, voffA);
            PG8_WAIT_V(8); PG8_WAIT_L(0); PG8_BAR; PG8_MMA(1, 0, At, B0); PG8_MMA(1, 1, At, B1); PG8_BAR; PG8_SCHED;
            } else {
            PG8_LDB(B0, 0, 0); PG8_SCHED; PG8_LDA(At, 0, 0); PG8_STAGE(PG8_SA(1, 1), a1 + hstep, voffA);
            PG8_WAIT_L(8); PG8_BAR; PG8_WAIT_L(0); PG8_MMA(0, 0, At, B0); PG8_BAR; PG8_SCHED;
            PG8_LDB(B1, 0, 1); PG8_STAGE(PG8_SB(0, 0), b2, voffB);
            PG8_BAR; PG8_WAIT_L(0); PG8_MMA(0, 1, At, B1); PG8_BAR;
            PG8_LDA(At, 0, 1); PG8_STAGE(PG8_SA(0, 0), a2, voffA);
            PG8_BAR; PG8_WAIT_L(0); PG8_MMA(1, 0, At, B0); PG8_BAR; PG8_SCHED;
            PG8_STAGE(PG8_SB(0, 1), b2 + hstep, voffB);
            PG8_WAIT_V(6); PG8_BAR; PG8_MMA(1, 1, At, B1); PG8_BAR;
            PG8_LDB(B0, 1, 0); PG8_SCHED; PG8_LDA(At, 1, 0); PG8_STAGE(PG8_SA(0, 1), a2 + hstep, voffA);
            PG8_WAIT_L(8); PG8_BAR; PG8_WAIT_L(0); PG8_MMA(0, 0, At, B0); PG8_BAR; PG8_SCHED;
            PG8_LDB(B1, 1, 1); PG8_STAGE(PG8_SB(1, 0), b3, voffB);
            PG8_BAR; PG8_WAIT_L(0); PG8_MMA(0, 1, At, B1); PG8_BAR;
            PG8_LDA(At, 1, 1); PG8_STAGE(PG8_SA(1, 0), a3, voffA);
            PG8_BAR; PG8_WAIT_L(0); PG8_MMA(1, 0, At, B0); PG8_BAR; PG8_SCHED;
            PG8_STAGE(PG8_SB(1, 1), b3 + hstep, voffB);
            PG8_WAIT_V(6); PG8_BAR; PG8_MMA(1, 1, At, B1); PG8_BAR;
            }
        }
        if constexpr (ALIGN_EPI) { if (wr == 0) PG8_BAR; }
        if constexpr (!Epi::AFTER_DRAIN) { E(acc, cur, wr, wc, fr, fq); S.done(cur); }
        if (!has_next) break;
#pragma unroll
        for (int a = 0; a < 2; ++a)
#pragma unroll
            for (int b = 0; b < 2; ++b)
#pragma unroll
                for (int m = 0; m < 4; ++m)
#pragma unroll
                    for (int n = 0; n < 2; ++n) acc[a][b][m][n] = (f32x4){0.f, 0.f, 0.f, 0.f};
        cur = nxt; cA = nA; cB = nB; ++ui;
        if constexpr (ALIGN_EPI) { if (wr == 1) PG8_BAR; }
    }
    PG8_WAIT_V(0);
    if constexpr (!ALIGN_EPI) { if (wr == 0) PG8_BAR; }
    PG8_BAR;
    if constexpr (Epi::AFTER_DRAIN) { E.fused(acc, cur, wr, wc, fr, fq, lds, wid, lane); S.done(cur); }
#undef PG8_SA
#undef PG8_SB
#undef PG8_STAGE
#undef PG8_LDA
#undef PG8_LDB
#undef PG8_MMA
#undef PG8_WAIT_V
#undef PG8_WAIT_L
#undef PG8_BAR
#undef PG8_SCHED
}
}
namespace fox {
typedef unsigned short bf16;
typedef short bf16x8 __attribute__((ext_vector_type(8)));
typedef short s16x4 __attribute__((ext_vector_type(4)));
typedef float f32x16 __attribute__((ext_vector_type(16)));
typedef float f32x4 __attribute__((ext_vector_type(4)));
typedef unsigned u32x4 __attribute__((ext_vector_type(4)));
typedef __attribute__((address_space(3))) char lchar;
constexpr int D = 128, NW = 8, QBLK = 32, KVBLK = 64, QB = NW * QBLK;
constexpr int SHM_V = KVBLK * D * 2, SHM_K = KVBLK * D * 2;
constexpr int OFF_WS = 2 * SHM_V + 2 * SHM_K, OFF_CK = OFF_WS + NW * 64 * 4, OFF_Q = OFF_CK + 2 * 64 * 4, LDS_BYTES = OFF_Q + NW * 8192;
constexpr float SCALE = 0.08838834764831845f;
constexpr float THR = 8.f;
#define FOX_KSWZ(row, colB) ((row) * 256 + ((colB) ^ (((row) & 7) << 4)))
#define FOX_SBAR() __builtin_amdgcn_sched_barrier(0)
__device__ __forceinline__ int v_st(int k, int c) { const int kk = (k & ~0xC) | ((k & 4) << 1) | ((k & 8) >> 1); return ((kk >> 3) * 4 + (c >> 5)) * 512 + ((kk & 7) * 32 + (c & 31)) * 2; }
__device__ __forceinline__ int v_rd_base(int lane) { return ((lane & 3) << 3) | (((lane >> 2) & 3) << 6) | (((lane >> 4) & 1) << 5) | (((lane >> 5) & 1) << 8); }
constexpr int v_rd_off(int d0, int ks, int half) { return d0 * 512 + ks * 4096 + half * 2048; }
__device__ __forceinline__ int crow(int r, int hi) { return (r & 3) + 8 * (r >> 2) + 4 * hi; }
__device__ __forceinline__ unsigned cvtpk(float lo, float hi) { return pg8::cvt_pk_bf16(lo, hi); }
__device__ __forceinline__ bf16x8 load8(const bf16* p) { return *reinterpret_cast<const bf16x8*>(p); }
__device__ __forceinline__ void mask_tile(f32x16& p0, f32x16& p1, int dq, unsigned W) {
    const float NEG = -__builtin_inff();
#pragma unroll
    for (int r = 0; r < 16; ++r) {
        const int c = (r & 3) + 8 * (r >> 2);
        if ((unsigned)(dq - c) >= W) p0[r] = NEG;
        if ((unsigned)(dq - c - 32) >= W) p1[r] = NEG;
    }
}
__device__ __forceinline__ void bias_tile(f32x16& p0, f32x16& p1, const lchar* ck, int hi) {
    const __attribute__((address_space(3))) float* c = (const __attribute__((address_space(3))) float*)ck + 4 * hi;
#pragma unroll
    for (int q = 0; q < 4; ++q) {
        const f32x4 a = *(const __attribute__((address_space(3))) f32x4*)(c + 8 * q), b = *(const __attribute__((address_space(3))) f32x4*)(c + 32 + 8 * q);
#pragma unroll
        for (int i = 0; i < 4; ++i) { p0[4 * q + i] += a[i]; p1[4 * q + i] += b[i]; }
    }
}
__device__ __forceinline__ void partialSM(f32x16& p0, f32x16& p1, float& m_reg, float& mn, float& alpha) {
    float pmax = p0[0];
#pragma unroll
    for (int r = 1; r < 16; ++r) pmax = fmaxf(pmax, p0[r]);
#pragma unroll
    for (int r = 0; r < 16; ++r) pmax = fmaxf(pmax, p1[r]);
    { auto rr = __builtin_amdgcn_permlane32_swap(__float_as_uint(pmax), __float_as_uint(pmax), false, false);
      pmax = fmaxf(__uint_as_float(rr[0]), __uint_as_float(rr[1])); }
    constexpr float C2 = 1.4426950408889634f * SCALE;
    if (__builtin_expect(__all((pmax - m_reg) * SCALE <= THR), 1)) { mn = m_reg; alpha = 1.f; }
    else { mn = fmaxf(m_reg, pmax); alpha = __builtin_amdgcn_exp2f((m_reg - mn) * C2); m_reg = mn; }
    const float mnL = -mn * C2;
#pragma unroll
    for (int r = 0; r < 16; ++r) p0[r] = fmaf(p0[r], C2, mnL);
#pragma unroll
    for (int r = 0; r < 16; ++r) p1[r] = fmaf(p1[r], C2, mnL);
#pragma unroll
    for (int r = 0; r < 16; ++r) p0[r] = __builtin_amdgcn_exp2f(p0[r]);
}
__device__ __forceinline__ void finishSM(f32x16& p0, f32x16& p1, float alpha, float& l_reg, bf16x8& pa0, bf16x8& pa1, bf16x8& pa2, bf16x8& pa3) {
#pragma unroll
    for (int r = 0; r < 16; ++r) p1[r] = __builtin_amdgcn_exp2f(p1[r]);
    float ps = 0;
#pragma unroll
    for (int r = 0; r < 16; ++r) ps += p0[r];
#pragma unroll
    for (int r = 0; r < 16; ++r) ps += p1[r];
    { auto rr = __builtin_amdgcn_permlane32_swap(__float_as_uint(ps), __float_as_uint(ps), false, false);
      ps = __uint_as_float(rr[0]) + __uint_as_float(rr[1]); }
    l_reg = l_reg * alpha + ps;
#define FOX_PK4(P, B_, OUT) do { unsigned a0 = cvtpk(P[B_+0], P[B_+1]), a1 = cvtpk(P[B_+2], P[B_+3]);                          \
        unsigned b0 = cvtpk(P[B_+4], P[B_+5]), b1 = cvtpk(P[B_+6], P[B_+7]);                                             \
        auto r0 = __builtin_amdgcn_permlane32_swap(a0, b0, false, false); auto r1 = __builtin_amdgcn_permlane32_swap(a1, b1, false, false); \
        u32x4 w = {r0[0], r1[0], r0[1], r1[1]}; OUT = __builtin_bit_cast(bf16x8, w); } while (0)
    FOX_PK4(p0, 0, pa0); FOX_PK4(p0, 8, pa1); FOX_PK4(p1, 0, pa2); FOX_PK4(p1, 8, pa3);
#undef FOX_PK4
}
template <int KB>
__device__ __forceinline__ void qkt(f32x16& p0, f32x16& p1, const lchar* K_lds, int r32, int hi, const lchar* qs) {
    p0 = f32x16{}; p1 = f32x16{};
    const lchar* kb[4];
#pragma unroll
    for (int dd = 0; dd < 4; ++dd) kb[dd] = K_lds + KB * SHM_K + FOX_KSWZ(r32, (dd * 16 + hi * 8) * 2);
#pragma unroll
    for (int d0 = 0; d0 < 8; ++d0) { const lchar* a = kb[d0 & 3] + (d0 >> 2) * 128;
        bf16x8 b0 = *reinterpret_cast<const __attribute__((address_space(3))) bf16x8*>(a);
        bf16x8 b1 = *reinterpret_cast<const __attribute__((address_space(3))) bf16x8*>(a + 32 * 256);
        const bf16x8 qf = *reinterpret_cast<const __attribute__((address_space(3))) bf16x8*>(qs + d0 * 1024);
        p0 = __builtin_amdgcn_mfma_f32_32x32x16_bf16(b0, qf, p0, 0, 0, 0);
        p1 = __builtin_amdgcn_mfma_f32_32x32x16_bf16(b1, qf, p1, 0, 0, 0); }
}
template <int VB>
__device__ __forceinline__ void pv_tile(f32x16* o, int vb0, bf16x8 pa0, bf16x8 pa1, bf16x8 pa2, bf16x8 pa3) {
#define FOX_TRRD(dst, off) asm volatile("ds_read_b64_tr_b16 %0, %1 offset:%2" : "=&v"(dst) : "v"(vb0), "i"(off) : "memory")
#define FOX_PV_D0(d0) do { s16x4 l0, l1, l2, l3, h0, h1, h2, h3; constexpr int b_ = VB * SHM_V + v_rd_off(d0, 0, 0); \
        FOX_TRRD(l0, b_); FOX_TRRD(h0, b_ + 2048); FOX_TRRD(l1, b_ + 4096); FOX_TRRD(h1, b_ + 6144); FOX_TRRD(l2, b_ + 8192); FOX_TRRD(h2, b_ + 10240); FOX_TRRD(l3, b_ + 12288); FOX_TRRD(h3, b_ + 14336); \
        asm volatile("s_waitcnt lgkmcnt(0)" ::: "memory"); FOX_SBAR();   \
        o[d0] = __builtin_amdgcn_mfma_f32_32x32x16_bf16(pa0, (bf16x8){l0[0], l0[1], l0[2], l0[3], h0[0], h0[1], h0[2], h0[3]}, o[d0], 0, 0, 0);   \
        o[d0] = __builtin_amdgcn_mfma_f32_32x32x16_bf16(pa1, (bf16x8){l1[0], l1[1], l1[2], l1[3], h1[0], h1[1], h1[2], h1[3]}, o[d0], 0, 0, 0);   \
        o[d0] = __builtin_amdgcn_mfma_f32_32x32x16_bf16(pa2, (bf16x8){l2[0], l2[1], l2[2], l2[3], h2[0], h2[1], h2[2], h2[3]}, o[d0], 0, 0, 0);   \
        o[d0] = __builtin_amdgcn_mfma_f32_32x32x16_bf16(pa3, (bf16x8){l3[0], l3[1], l3[2], l3[3], h3[0], h3[1], h3[2], h3[3]}, o[d0], 0, 0, 0); } while (0)
    FOX_PV_D0(0); FOX_PV_D0(1); FOX_PV_D0(2); FOX_PV_D0(3);
#undef FOX_PV_D0
#undef FOX_TRRD
}
struct BlockRef { const bf16* Q; const bf16* K; const bf16* V; bf16* O; const float* NCK; int P0; };
struct Seam { bf16x8 qr[8]; bf16x8 st_v0, st_v1, st_k0, st_k1; };
#define FOX_ROW(p, k0, rr) ((p) + (size_t)((k0) + (rr)) * PQ + sc)
#define FOX_VMW() asm volatile("s_waitcnt vmcnt(0)" ::: "memory")
#define FOX_VMWN(n) asm volatile("s_waitcnt vmcnt(%0)" :: "i"(n) : "memory")
#define FOX_SLOAD(Kp, Vp, Cp, k0, cb) do { S.st_v0 = load8(FOX_ROW(Vp, k0, sr)); S.st_v1 = load8(FOX_ROW(Vp, k0, 32 + sr));              \
                         S.st_k0 = load8(FOX_ROW(Kp, k0, sr)); S.st_k1 = load8(FOX_ROW(Kp, k0, 32 + sr)); \
                         if (wid == 0) __builtin_amdgcn_global_load_lds((const unsigned*)((Cp) + (k0) + lane), (__attribute__((address_space(3))) unsigned*)(CK_lds + (cb) * 64), 4, 0, 0); } while (0)
#define FOX_SWRITE_K(bf) do { *(__attribute__((address_space(3))) bf16x8*)(K_lds + (bf) * SHM_K + kws) = S.st_k0; *(__attribute__((address_space(3))) bf16x8*)(K_lds + (bf) * SHM_K + kws + 32 * 256) = S.st_k1; \
                              } while (0)
#define FOX_SWRITE_V(bf) do { *(__attribute__((address_space(3))) bf16x8*)(V_lds + (bf) * SHM_V + vst0) = S.st_v0; *(__attribute__((address_space(3))) bf16x8*)(V_lds + (bf) * SHM_V + vst1) = S.st_v1; } while (0)
#define FOX_SWRITE(bf) do { FOX_SWRITE_V(bf); FOX_SWRITE_K(bf); } while (0)
template <int PQ, int PO>
__device__ __forceinline__ void fox_prime(const BlockRef& cur, lchar* lds, Seam& S) {
    const int tid = tid_local(), wid = __builtin_amdgcn_readfirstlane(tid >> 6), lane = tid & 63, r32 = lane & 31, hi = lane >> 5;
    const int sr = tid >> 4, sc = (tid & 15) * 8, kws = FOX_KSWZ(sr, sc * 2); lchar* K_lds = lds + 2 * SHM_V;
    __attribute__((address_space(3))) float* CK_lds = (__attribute__((address_space(3))) float*)(lds + OFF_CK);
#pragma unroll
    for (int d0 = 0; d0 < 8; ++d0) S.qr[d0] = load8(cur.Q + (size_t)(wid * QBLK + r32) * PQ + d0 * 16 + hi * 8);
    FOX_SLOAD(cur.K, cur.V, cur.NCK, 0, 0); FOX_VMW(); FOX_SWRITE_K(0);
    __syncthreads();
}
template <int PQ, int PO>
__device__ __forceinline__ void fox_block(const BlockRef& cur, const BlockRef& nxt, lchar* lds, Seam& S) {
    const int tid = tid_local(), wid = __builtin_amdgcn_readfirstlane(tid >> 6), lane = tid & 63, r32 = lane & 31, hi = lane >> 5;
    constexpr unsigned W = 1u << 30;
    const int NT = (cur.P0 + QB - 1) / KVBLK + 1;
    const int qlo = cur.P0 + wid * QBLK, qm = qlo + r32 - 4 * hi;
    lchar* V_lds = lds; lchar* K_lds = lds + 2 * SHM_V;
    __attribute__((address_space(3))) float* ws = (__attribute__((address_space(3))) float*)(lds + OFF_WS) + wid * 64; __attribute__((address_space(3))) float* li_l = ws; __attribute__((address_space(3))) float* al_l = ws + 32;
    __attribute__((address_space(3))) float* CK_lds = (__attribute__((address_space(3))) float*)(lds + OFF_CK);
    float m_reg = -1e30f, l_reg = 0; f32x16 o[4] = {};
    const int sr = tid >> 4, sc = (tid & 15) * 8, vst0 = v_st(sr, sc), vst1 = v_st(32 + sr, sc), kws = FOX_KSWZ(sr, sc * 2);
    const int vb0 = (int)(unsigned)(uintptr_t)V_lds + v_rd_base(lane);
    const bf16* Kh = cur.K; const bf16* Vh = cur.V; const float* Ch = cur.NCK;
#define FOX_RESC(a) do { if (__any((a) < 1.f)) { if (hi == 0) al_l[r32] = (a); asm volatile("s_waitcnt lgkmcnt(0)" ::: "memory");              \
                     _Pragma("unroll") for (int d_ = 0; d_ < 4; ++d_) _Pragma("unroll") for (int r = 0; r < 16; ++r) o[d_][r] *= al_l[crow(r, hi)]; } } while (0)
#define FOX_KBASE(t) ((t) * KVBLK)
#define FOX_MASKT(P0_, P1_, t, KB) do { const int kb_ = FOX_KBASE(t); bias_tile(P0_, P1_, (const lchar*)(CK_lds + (KB) * 64), hi); if (kb_ + KVBLK - 1 > qlo) mask_tile(P0_, P1_, qm - kb_, W); } while (0)
    constexpr int NQL = 8;
#define FOX_SEAM_K0() do { FOX_VMWN(NQL); FOX_SWRITE_K(0); FOX_SBAR(); } while (0)
    f32x16 pA0, pA1, pB0, pB1; float mnA, mnB, alA, alB; bf16x8 pa0, pa1, pa2, pa3;
    lchar* qs = lds + OFF_Q + wid * 8192 + lane * 16;
    FOX_VMW();
#pragma unroll
    for (int d0 = 0; d0 < 8; ++d0) *reinterpret_cast<__attribute__((address_space(3))) bf16x8*>(qs + d0 * 1024) = S.qr[d0];
    FOX_SWRITE_V(0); FOX_SBAR();
    if (NT > 1) { FOX_SLOAD(Kh, Vh, Ch, FOX_KBASE(1), 1); }
    FOX_SBAR(); qkt<0>(pA0, pA1, K_lds, r32, hi, qs);
    FOX_MASKT(pA0, pA1, 0, 0); partialSM(pA0, pA1, m_reg, mnA, alA);
    if (NT > 1) { FOX_VMW(); FOX_SWRITE(1); }
    __syncthreads();
#define FOX_HALF_STEP(PX0, PX1, mnX, alX, PY0, PY1, alY, t, KB, VB, SB) do {                                                      \
        FOX_SBAR(); qkt<KB>(PX0, PX1, K_lds, r32, hi, qs);                                             \
        finishSM(PY0, PY1, alY, l_reg, pa0, pa1, pa2, pa3); FOX_SBAR();                                                           \
        if ((t) + 1 < NT) { FOX_SLOAD(Kh, Vh, Ch, FOX_KBASE((t) + 1), SB); FOX_SBAR(); }                                               \
        pv_tile<VB>(o, vb0, pa0, pa1, pa2, pa3); FOX_MASKT(PX0, PX1, (t), KB); partialSM(PX0, PX1, m_reg, mnX, alX);                                        \
        __syncthreads();                                                                                                      \
        if ((t) + 1 < NT) { FOX_VMW(); FOX_SWRITE(SB); }                                                                          \
        FOX_RESC(alX); __syncthreads(); } while (0)
    for (int t = 1; t + 1 < NT; t += 2) {
        FOX_HALF_STEP(pB0, pB1, mnB, alB, pA0, pA1, alA, t, 1, 0, 0);
        FOX_HALF_STEP(pA0, pA1, mnA, alA, pB0, pB1, alB, t + 1, 0, 1, 1);
    }
    const bool even = (NT & 1) == 0;
    if (even) { FOX_SBAR(); qkt<1>(pB0, pB1, K_lds, r32, hi, qs); FOX_SBAR(); }
    FOX_SLOAD(nxt.K, nxt.V, nxt.NCK, 0, 0); FOX_SBAR();
#pragma unroll
    for (int d0 = 0; d0 < 8; ++d0) S.qr[d0] = load8(nxt.Q + (size_t)(wid * QBLK + r32) * PQ + d0 * 16 + hi * 8);
    FOX_SBAR();
    finishSM(pA0, pA1, alA, l_reg, pa0, pa1, pa2, pa3); FOX_SBAR();
    pv_tile<0>(o, vb0, pa0, pa1, pa2, pa3);
    if (even) { FOX_MASKT(pB0, pB1, NT - 1, 1); partialSM(pB0, pB1, m_reg, mnB, alB); __syncthreads(); FOX_RESC(alB);
        finishSM(pB0, pB1, alB, l_reg, pa0, pa1, pa2, pa3); FOX_SBAR(); pv_tile<1>(o, vb0, pa0, pa1, pa2, pa3); }
    FOX_SBAR(); FOX_SEAM_K0();
    if (hi == 0) li_l[r32] = l_reg; asm volatile("s_waitcnt lgkmcnt(0)" ::: "memory");
    float rli[16];
#pragma unroll
    for (int r = 0; r < 16; ++r) rli[r] = __builtin_amdgcn_rcpf(li_l[crow(r, hi)]);
    bf16* Ow = cur.O + (size_t)(wid * QBLK) * PO;
#pragma unroll
    for (int r = 0; r < 16; ++r) { const int orow = crow(r, hi);
#pragma unroll
        for (int d0 = 0; d0 < 4; ++d0) { const float v = o[d0][r] * rli[r];
            const float vn = __shfl_xor(v, 1);
            if ((r32 & 1) == 0) *(unsigned*)(Ow + (size_t)orow * PO + d0 * 32 + r32) = cvtpk(v, vn); } }
    __syncthreads();
#undef FOX_RESC
#undef FOX_KBASE
#undef FOX_MASKT
#undef FOX_SEAM_K0
#undef FOX_HALF_STEP
}
#undef FOX_ROW
#undef FOX_VMW
#undef FOX_VMWN
#undef FOX_SLOAD
#undef FOX_SWRITE_K
#undef FOX_SWRITE_V
#undef FOX_SWRITE
}
constexpr int NWAVES = 8, NTHR = 512;
constexpr int BATCH = 4, SEQ = 4096, DM = 4096, M = BATCH * SEQ, DEPTH = 2;
constexpr int POOL_DIM = 1024, ATTN_DIM = 1536, GDN_DIM = 1536, NH = 12, HD = 128;
constexpr int IN_DIM = 11812, NPROJ = 12032  , PQ = 11776  ;
constexpr int FFN = 11008, FFN2 = 22016;
constexpr int C_POOL = 0, C_FQ = 1024, C_FK = 2560, C_FV = 4096, C_GQ = 5632, C_GK = 7168, C_GV = 8704, C_GZ = 10240, PN_SMALL = 46;
constexpr int SM_FF = 0, SM_GB = 12, SM_GA = 24;
constexpr float EPS = 1e-6f;
constexpr int NCHUNK = SEQ / 64;
constexpr int NUNIT_GDN = BATCH * NH * NCHUNK;

constexpr size_t MiB = 1u << 20;
constexpr size_t WS_CTL = 0, CTL_ZERO_BYTES = 1 * MiB;
constexpr size_t SZ_WIN = (size_t)NPROJ * DM * 2, SZ_WO = (size_t)DM * DM * 2, SZ_WUP = (size_t)FFN2 * DM * 2, SZ_WDN = (size_t)DM * FFN * 2, SZ_PW = (size_t)4 * 256 * 256 * 2;
constexpr size_t WS_WIN = 1 * MiB, WS_WO = WS_WIN + 2 * SZ_WIN, WS_WUP = WS_WO + 2 * SZ_WO, WS_WDN = WS_WUP + 2 * SZ_WUP, WS_PW = WS_WDN + 2 * SZ_WDN;
constexpr size_t WS_XN = ((WS_PW + 2 * SZ_PW + MiB - 1) / MiB) * MiB;
constexpr size_t WS_X = WS_XN + (size_t)M * DM * 2;
constexpr size_t WS_OV = WS_X + (size_t)M * DM * 4;
constexpr size_t WS_PROJ = WS_OV, WS_SMALL = WS_PROJ + (size_t)M * PQ * 2, WS_MIX = WS_SMALL + (size_t)M * 64 * 4;
constexpr size_t WS_NEGW = WS_MIX + (size_t)M * DM * 2;
constexpr size_t WS_QDEC = WS_NEGW + (size_t)NUNIT_GDN * 8192 * 2;
constexpr size_t WS_KDT = WS_QDEC + (size_t)NUNIT_GDN * 8192 * 2;
constexpr size_t WS_INTRA = WS_KDT + (size_t)NUNIT_GDN * 8192 * 2;
constexpr size_t WS_UT = WS_INTRA + (size_t)NUNIT_GDN * 4096 * 2;
constexpr size_t WS_EGL = WS_UT + (size_t)NUNIT_GDN * 8192 * 4;
constexpr size_t WS_NCK = WS_EGL + 16384;
constexpr size_t WS_OV_END1 = WS_NCK + (size_t)BATCH * NH * SEQ * 4;
constexpr size_t WS_U = WS_OV;
constexpr size_t WS_OV_END2 = WS_U + (size_t)M * FFN2 * 2;
constexpr size_t WS_ACT = ((((WS_OV_END1 > WS_OV_END2) ? WS_OV_END1 : WS_OV_END2) + MiB - 1) / MiB) * MiB;
constexpr size_t WS_END = WS_ACT + (size_t)M * FFN * 2;
static_assert(WS_END <= (size_t)2752 * MiB, "d_ws map exceeds the guaranteed workspace");

constexpr int CW_TMO = 0, CW_CODE = 1, CW_BAR = 4096;

constexpr int RING_BYTES = 139264, LDSCTL_OFF = RING_BYTES, MISC_OFF = LDSCTL_OFF + 320, LDS_BYTES = 147456;
#define GAS __attribute__((address_space(1)))
#define LAS __attribute__((address_space(3)))
typedef unsigned short bf16;
typedef unsigned v4u __attribute__((ext_vector_type(4)));
typedef float f32x4 __attribute__((ext_vector_type(4)));
typedef short bf16x8 __attribute__((ext_vector_type(8)));
typedef GAS unsigned gu32;
typedef GAS unsigned long long gu64;
#define RLX_AGENT __ATOMIC_RELAXED, __HIP_MEMORY_SCOPE_AGENT
#define LDS_WAIT() asm volatile("s_waitcnt lgkmcnt(0)" ::: "memory")
#define VM_WAIT() asm volatile("s_waitcnt vmcnt(0)" ::: "memory")
__device__ __forceinline__ unsigned long long rt() { return __builtin_amdgcn_s_memrealtime(); }
__device__ __forceinline__ unsigned f2bf(float f) { unsigned u = __builtin_bit_cast(unsigned, f); return (u + 0x7fffu + ((u >> 16) & 1u)) >> 16; }
__device__ __forceinline__ unsigned pk2(float lo, float hi) { return f2bf(lo) | (f2bf(hi) << 16); }

#define XB_TMO      128
#define XB_XCNT(j)  (256  + 64 * (j))
#define XB_XSUB(j)  (1280 + 64 * (j))
#define XB_XGEN(j)  (2304 + 64 * (j))
#define XB_TOP      3328
#define XB_TOPGEN   3392
#define XCD_BAR_WORDS 3456
#define XB_SPIN_CAP (1u << 18)

__device__ __forceinline__ unsigned xb_ld(unsigned* p)              { return __hip_atomic_load(p, __ATOMIC_RELAXED, __HIP_MEMORY_SCOPE_AGENT); }
__device__ __forceinline__ unsigned xb_add(unsigned* p, unsigned v) { return __hip_atomic_fetch_add(p, v, __ATOMIC_RELAXED, __HIP_MEMORY_SCOPE_AGENT); }
__device__ __forceinline__ unsigned xb_xcc_id() { return (unsigned)__builtin_amdgcn_s_getreg((3 << 11) | 20) & 0xFu; }
#define XB_SPIN(cond, bar) do { unsigned _sp = 0; while (cond) { __builtin_amdgcn_s_sleep(1); \
    if ((++_sp & 255u) == 0u) { if (xb_ld(&(bar)[XB_TMO])) break; if (_sp > XB_SPIN_CAP) { atomicAdd(&(bar)[XB_TMO], 1u); break; } } } } while (0)

struct XcdBarrier {
    unsigned* bar; unsigned x;
    volatile LAS unsigned* st;
};

__device__ __forceinline__ XcdBarrier xcd_barrier_post(unsigned* bar, volatile LAS unsigned* st) {
    XcdBarrier b; b.bar = bar; b.x = xb_xcc_id(); b.st = st;
    if (threadIdx.x == 0) (void)xb_add(&bar[XB_XCNT(b.x)], 1u);
    return b;
}
__device__ __forceinline__ void xcd_barrier_complete(unsigned* bar, unsigned x, unsigned& nloc, unsigned& nx) {
    const unsigned G = gridDim.x * gridDim.y * gridDim.z;
    unsigned sum, cnt, mine, sp = 0u;
    for (;;) {
        sum = 0u; cnt = 0u; mine = 0u;
#pragma unroll
        for (unsigned j = 0; j < 16; ++j) { const unsigned c = xb_ld(&bar[XB_XCNT(j)]); sum += c; cnt += (c > 0u) ? 1u : 0u; mine = (j == x) ? c : mine; }
        if (sum == G) break;
        __builtin_amdgcn_s_sleep(1);
        if ((++sp & 255u) == 0u) { if (xb_ld(&bar[XB_TMO])) break; if (sp > XB_SPIN_CAP) { atomicAdd(&bar[XB_TMO], 1u); break; } }
    }
    nloc = mine > 0u ? mine : 1u; nx = cnt > 0u ? cnt : 1u;
}

__device__ __forceinline__ void xcd_barrier(const XcdBarrier& b) {
    asm volatile("s_waitcnt vmcnt(0)" ::: "memory");
    __syncthreads();
    if (threadIdx.x == 0) {
        unsigned* bar = b.bar;
        __builtin_amdgcn_s_waitcnt(0);
        unsigned nloc = b.st[0], nx = b.st[1];
        if (nloc == 0u) { xcd_barrier_complete(bar, b.x, nloc, nx); b.st[0] = nloc; b.st[1] = nx; }
        const unsigned old = xb_add(&bar[XB_XSUB(b.x)], 1u);
        const unsigned gen = old / nloc;
        if (old + 1u == (gen + 1u) * nloc) {
            __builtin_amdgcn_fence(__ATOMIC_RELEASE, "agent");
            asm volatile("s_waitcnt vmcnt(0)" ::: "memory");
            const unsigned og = xb_add(&bar[XB_TOP], 1u);
            const unsigned tg = og / nx;
            if (og + 1u == (tg + 1u) * nx) xb_add(&bar[XB_TOPGEN], 1u);
            else XB_SPIN(xb_ld(&bar[XB_TOPGEN]) == tg, bar);
            __builtin_amdgcn_fence(__ATOMIC_ACQUIRE, "agent");
            xb_add(&bar[XB_XGEN(b.x)], 1u);
            asm volatile("s_waitcnt vmcnt(0)" ::: "memory");
        } else {
            XB_SPIN(xb_ld(&bar[XB_XGEN(b.x)]) == gen, bar);
            __builtin_amdgcn_fence(__ATOMIC_ACQUIRE, "agent");
            asm volatile("s_waitcnt vmcnt(0)" ::: "memory");
        }
    }
    __syncthreads();
}

typedef unsigned u32x2 __attribute__((ext_vector_type(2)));
typedef float f32x2 __attribute__((ext_vector_type(2)));
typedef LAS unsigned char* lptr;
struct Frame {
    lptr lds; int tid, lane, wave, G, bx, z;
    unsigned char* ws; const float* const __attribute__((address_space(4)))* ka;
};
#define WSP(type, off) ((type*)(F.ws + (size_t)(off) + (size_t)(unsigned)F.z))
#define INP(k) ((const float*)F.ka[(k) + F.z])
#define PHASE_LOCAL() do { asm volatile("s_mov_b32 %0, 0" : "=s"(F.z)); F.tid = tid_local(); F.lane = F.tid & 63; F.wave = __builtin_amdgcn_readfirstlane(F.tid >> 6); } while (0)
__device__ __forceinline__ float bf2f(unsigned b) { return __builtin_bit_cast(float, b << 16); }
__device__ __forceinline__ float wave_sum(float v) {
#pragma unroll
    for (int o = 1; o < 64; o <<= 1) v += __shfl_xor(v, o);
    return v;
}
__device__ __forceinline__ void unpack8(const v4u w, float (&f)[8]) {
    f[0] = bf2f(w.x & 0xffffu); f[1] = __builtin_bit_cast(float, w.x & 0xffff0000u); f[2] = bf2f(w.y & 0xffffu); f[3] = __builtin_bit_cast(float, w.y & 0xffff0000u);
    f[4] = bf2f(w.z & 0xffffu); f[5] = __builtin_bit_cast(float, w.z & 0xffff0000u); f[6] = bf2f(w.w & 0xffffu); f[7] = __builtin_bit_cast(float, w.w & 0xffff0000u);
}
__device__ __forceinline__ v4u pack8(const float (&f)[8]) { v4u w; w.x = pk2(f[0], f[1]); w.y = pk2(f[2], f[3]); w.z = pk2(f[4], f[5]); w.w = pk2(f[6], f[7]); return w; }
__device__ __forceinline__ float silu_f(float x) { return x / (1.f + __expf(-x)); }
__device__ __forceinline__ float softplus_f(float x) { return fmaxf(x, 0.f) + log1pf(__expf(-fabsf(x))); }
#define WG_BAR() __syncthreads()

__device__ __forceinline__ void transpose_item(const float* W, int K, int Ns, bf16* WT, LAS float* scr, int kb, int nb, int srcc, int lane) {
    const int k0 = 64 * kb, n0 = 32 * nb;
#pragma unroll 8
    for (int i = 0; i < 32; ++i) { const int kk = 2 * i + (lane >> 5); scr[kk * 33 + (lane & 31)] = srcc >= 0 ? W[(size_t)(k0 + kk) * Ns + srcc] : 0.f; }
    LDS_WAIT(); asm volatile("" ::: "memory");
    const int c = lane & 7;
#pragma unroll
    for (int j = 0; j < 4; ++j) { const int n = (lane >> 3) + 8 * j; const LAS float* s = scr + (8 * c) * 33 + n;
        v4u o; o.x = pk2(s[0 * 33], s[1 * 33]); o.y = pk2(s[2 * 33], s[3 * 33]); o.z = pk2(s[4 * 33], s[5 * 33]); o.w = pk2(s[6 * 33], s[7 * 33]);
        *(v4u*)(WT + (size_t)(n0 + n) * K + k0 + 8 * c) = o; }
    LDS_WAIT(); asm volatile("" ::: "memory");
}
__device__ __forceinline__ int map_win(int d) { return d < 5632 ? d : (d < 11776 ? d + 12 : (d < 11788 ? d - 6144 : (d < IN_DIM ? d : -1))); }
__device__ __forceinline__ int map_wup(int d) { const int p = d >> 8, j = d & 255; return j < 128 ? 128 * p + j : FFN + 128 * p + (j - 128); }
__device__ __forceinline__ void p0_prologue(Frame& F) {
    bf16* const WinT = WSP(bf16, WS_WIN); bf16* const WoT = WSP(bf16, WS_WO); bf16* const WupT = WSP(bf16, WS_WUP); bf16* const WdnT = WSP(bf16, WS_WDN); bf16* const PWT = WSP(bf16, WS_PW); const float* const w_in = INP(2); const float* const pool_w = INP(3); const float* const w_o = INP(10); const float* const w_up = INP(12); const float* const w_down = INP(14);
    LAS float* scr = (LAS float*)(F.lds + F.wave * 16384);
    const int gw = F.bx * NWAVES + F.wave, NGW = F.G * NWAVES, lane = F.lane;
    constexpr int NB_IN = NPROJ / 32, NB_O = DM / 32, NB_UP = FFN2 / 32, NB_DN = DM / 32;
    constexpr int I_IN = (DM / 64) * NB_IN, I_O = (DM / 64) * NB_O, I_UP = (DM / 64) * NB_UP, I_DN = (FFN / 64) * NB_DN, I_PW = 4 * 4 * 8;
    constexpr int NPER = I_IN + I_O + I_UP + I_DN + I_PW;
    for (int it = gw; it < DEPTH * NPER; it += NGW) {
        const int l = it / NPER; int r = it - l * NPER;
        if (r < I_IN) { const int kb = r / NB_IN, nb = r % NB_IN; transpose_item(w_in + (size_t)l * DM * IN_DIM, DM, IN_DIM, WinT + (size_t)l * NPROJ * DM, scr, kb, nb, map_win(32 * nb + (lane & 31)), lane); continue; } r -= I_IN;
        if (r < I_O) { const int kb = r / NB_O, nb = r % NB_O; transpose_item(w_o + (size_t)l * DM * DM, DM, DM, WoT + (size_t)l * DM * DM, scr, kb, nb, 32 * nb + (lane & 31), lane); continue; } r -= I_O;
        if (r < I_UP) { const int kb = r / NB_UP, nb = r % NB_UP; transpose_item(w_up + (size_t)l * DM * FFN2, DM, FFN2, WupT + (size_t)l * FFN2 * DM, scr, kb, nb, map_wup(32 * nb + (lane & 31)), lane); continue; } r -= I_UP;
        if (r < I_DN) { const int kb = r / NB_DN, nb = r % NB_DN; transpose_item(w_down + (size_t)l * FFN * DM, FFN, DM, WdnT + (size_t)l * DM * FFN, scr, kb, nb, 32 * nb + (lane & 31), lane); continue; } r -= I_DN;
        { const int g = r >> 5, kb = (r >> 3) & 3, nb = r & 7; transpose_item(pool_w + (size_t)(l * 4 + g) * 65536, 256, 256, PWT + (size_t)(l * 4 + g) * 65536, scr, kb, nb, 32 * nb + (lane & 31), lane); }
    }
}

__device__ __forceinline__ void rms_rows_bf16(Frame& F, const float* X, const float* gain, bf16* O) {
    const int gw = F.bx * NWAVES + F.wave, NGW = F.G * NWAVES;
    for (int m = gw; m < M; m += NGW) {
        const f32x4* xr = (const f32x4*)(X + (size_t)m * DM) + F.lane; const f32x4* gr = (const f32x4*)gain + F.lane;
        f32x4 v[16]; float s = 0.f;
#pragma unroll
        for (int j = 0; j < 16; ++j) { v[j] = xr[64 * j]; s += (v[j].x * v[j].x + v[j].y * v[j].y) + (v[j].z * v[j].z + v[j].w * v[j].w); }
        const float r = rsqrtf(wave_sum(s) * (1.f / DM) + EPS);
        unsigned long long* o8 = (unsigned long long*)(O + (size_t)m * DM) + F.lane;
#pragma unroll
        for (int j = 0; j < 16; ++j) { const f32x4 g = gr[64 * j]; o8[64 * j] = (unsigned long long)pk2(v[j].x * r * g.x, v[j].y * r * g.y) | ((unsigned long long)pk2(v[j].z * r * g.z, v[j].w * r * g.w) << 32); }
    }
}
__device__ __forceinline__ void rms_rows_f32(Frame& F, const float* X, const float* gain, float* O) {
    const int gw = F.bx * NWAVES + F.wave, NGW = F.G * NWAVES;
    for (int m = gw; m < M; m += NGW) {
        const f32x4* xr = (const f32x4*)(X + (size_t)m * DM) + F.lane; const f32x4* gr = (const f32x4*)gain + F.lane;
        f32x4 v[16]; float s = 0.f;
#pragma unroll
        for (int j = 0; j < 16; ++j) { v[j] = xr[64 * j]; s += (v[j].x * v[j].x + v[j].y * v[j].y) + (v[j].z * v[j].z + v[j].w * v[j].w); }
        const float r = rsqrtf(wave_sum(s) * (1.f / DM) + EPS);
        f32x4* o = (f32x4*)(O + (size_t)m * DM) + F.lane;
#pragma unroll
        for (int j = 0; j < 16; ++j) { const f32x4 g = gr[64 * j]; o[64 * j] = v[j] * r * g; }
    }
}

__device__ __forceinline__ void pool_phase(Frame& F, int layer) {
    bf16* const PWT = WSP(bf16, WS_PW); bf16* const PROJ = WSP(bf16, WS_PROJ); bf16* const MIX = WSP(bf16, WS_MIX); const float* const pool_scale = INP(4);
    LAS bf16* P = (LAS bf16*)F.lds;
    constexpr int PST = 264;
    const bf16* PW = PWT + (size_t)layer * 4 * 65536; const float* scale = pool_scale + layer * POOL_DIM;
    const int tid = F.tid, lane = F.lane, w = F.wave;
    for (int u = F.bx; u < (M / 64) * 4; u += F.G) {
        const int tile = u >> 2, g = u & 3, win = 2 << g, m0 = tile * 64, tseq0 = m0 & (SEQ - 1);
        {
            const int c8 = tid & 31, tq = tid >> 5, t0 = 4 * tq;
            const bf16* src = PROJ + (size_t)m0 * PQ + C_POOL + g * 256 + c8 * 8;
            float s[8];
#pragma unroll
            for (int e = 0; e < 8; ++e) s[e] = 0.f;
            for (int j = t0 - win + 1; j < t0; ++j) if (tseq0 + j >= 0) { float v[8]; unpack8(*(const v4u*)(src + (ptrdiff_t)j * PQ), v);
#pragma unroll
                for (int e = 0; e < 8; ++e) s[e] += v[e]; }
#pragma unroll
            for (int i = 0; i < 4; ++i) { const int t = t0 + i; float cur[8]; unpack8(*(const v4u*)(src + (ptrdiff_t)t * PQ), cur);
#pragma unroll
                for (int e = 0; e < 8; ++e) s[e] += cur[e];
                const int pos = tseq0 + t + 1; const float inv = 1.f / (float)(pos < win ? pos : win); float o[8];
#pragma unroll
                for (int e = 0; e < 8; ++e) o[e] = s[e] * inv - cur[e];
                *(LAS v4u*)(P + t * PST + c8 * 8) = pack8(o);
                const int jj = t - win + 1;
                if (tseq0 + jj >= 0) { float v[8]; unpack8(*(const v4u*)(src + (ptrdiff_t)jj * PQ), v);
#pragma unroll
                    for (int e = 0; e < 8; ++e) s[e] -= v[e]; } }
        }
        WG_BAR();
        {
            f32x4 acc[2][4];
#pragma unroll
            for (int a = 0; a < 2; ++a)
#pragma unroll
                for (int b = 0; b < 4; ++b) acc[a][b] = (f32x4){0.f, 0.f, 0.f, 0.f};
            const int r16 = lane & 15, q4 = lane >> 4;
#pragma unroll 2
            for (int ks = 0; ks < 8; ++ks) {
                bf16x8 wf[2], pf[4];
#pragma unroll
                for (int ne = 0; ne < 2; ++ne) wf[ne] = *(const bf16x8*)(PW + (size_t)(g * 256 + 32 * w + 16 * ne + r16) * 256 + 32 * ks + 8 * q4);
#pragma unroll
                for (int tt = 0; tt < 4; ++tt) pf[tt] = *(const LAS bf16x8*)(P + (16 * tt + r16) * PST + 32 * ks + 8 * q4);
#pragma unroll
                for (int ne = 0; ne < 2; ++ne)
#pragma unroll
                    for (int tt = 0; tt < 4; ++tt) acc[ne][tt] = __builtin_amdgcn_mfma_f32_16x16x32_bf16(wf[ne], pf[tt], acc[ne][tt], 0, 0, 0);
            }
#pragma unroll
            for (int ne = 0; ne < 2; ++ne) { const int e = 32 * w + 16 * ne + 4 * q4; const f32x4 sc = *(const f32x4*)(scale + g * 256 + e);
#pragma unroll
                for (int tt = 0; tt < 4; ++tt) { const int t = 16 * tt + r16; const f32x4 v = acc[ne][tt] * sc;
                    u32x2 o; o.x = pk2(v.x, v.y); o.y = pk2(v.z, v.w);
                    *(u32x2*)(MIX + (size_t)(m0 + t) * DM + g * 256 + e) = o; } }
        }
        WG_BAR();
    }
}

__device__ __forceinline__ void fox_cum_phase(Frame& F, int layer) {
    float* const SMALL = WSP(float, WS_SMALL); float* const NCK = WSP(float, WS_NCK); const float* const fox_bias = INP(5);
    const int gw = F.bx * NWAVES + F.wave, NGW = F.G * NWAVES, lane = F.lane;
    for (int bh = gw; bh < BATCH * NH; bh += NGW) {
        const int b = bh / NH, h = bh % NH; const float fb = fox_bias[layer * NH + h];
        const float* src = SMALL + (size_t)(b * SEQ + lane * 64) * 64 + SM_FF + h;
        float s = 0.f;
#pragma unroll 16
        for (int i = 0; i < 64; ++i) { const float xx = src[(size_t)i * 64] + fb; s += fminf(xx, 0.f) - log1pf(__expf(-fabsf(xx))); }
        float inc = s;
#pragma unroll
        for (int off = 1; off < 64; off <<= 1) { const float v = __shfl_up(inc, off); if (lane >= off) inc += v; }
        float run = inc - s;
        float* dst = NCK + (size_t)bh * SEQ + lane * 64;
#pragma unroll 16
        for (int i = 0; i < 64; ++i) { const float xx = src[(size_t)i * 64] + fb; run += fminf(xx, 0.f) - log1pf(__expf(-fabsf(xx))); dst[i] = -run * 11.313708498984761f; }
    }
}

constexpr int GP_RHS = 0, GP_KB = 65536, GP_QB = GP_KB + 64 * 136 * 2, GP_AL = GP_QB + 64 * 136 * 2, GP_GT = GP_AL + 64 * 64 * 4, GP_END = GP_GT + 768;
static_assert(GP_END <= RING_BYTES, "gdn prep LDS");
__device__ __forceinline__ void gdn_prep_phase(Frame& F, int layer) {
    bf16* const PROJ = WSP(bf16, WS_PROJ); bf16* const NEGW = WSP(bf16, WS_NEGW); bf16* const QDEC = WSP(bf16, WS_QDEC); bf16* const KDT = WSP(bf16, WS_KDT); bf16* const INTRA = WSP(bf16, WS_INTRA); float* const SMALL = WSP(float, WS_SMALL); float* const UT = WSP(float, WS_UT); float* const EGL = WSP(float, WS_EGL); const float* const gconv_w = INP(6); const float* const g_Alog = INP(7); const float* const g_dtb = INP(8);
    LAS float* RHS = (LAS float*)(F.lds + GP_RHS);
    LAS bf16* KB = (LAS bf16*)(F.lds + GP_KB);
    LAS bf16* QB = (LAS bf16*)(F.lds + GP_QB);
    LAS float* AL = (LAS float*)(F.lds + GP_AL);
    LAS float* GT = (LAS float*)(F.lds + GP_GT);
    const int tid = F.tid, lane = F.lane, w = F.wave;
    const float* convw = gconv_w + (size_t)layer * 4 * (3 * GDN_DIM);
    for (int u = F.bx; u < NUNIT_GDN; u += F.G) {
        const int bh = u >> 6, n = u & 63, b = bh / NH, h = bh % NH, m0 = b * SEQ + n * 64;
        if (w == 0) {
            const int m = m0 + lane;
            const float a = SMALL[(size_t)m * 64 + SM_GA + h], bb = SMALL[(size_t)m * 64 + SM_GB + h];
            const float beta = 1.f / (1.f + __expf(-bb));
            float g = -__expf(g_Alog[layer * NH + h]) * softplus_f(a + g_dtb[layer * NH + h]);
#pragma unroll
            for (int off = 1; off < 64; off <<= 1) { const float v = __shfl_up(g, off); if (lane >= off) g += v; }
            GT[lane] = g; GT[64 + lane] = beta; GT[128 + lane] = __expf(g);
        }
        WG_BAR();
#pragma unroll 1
        for (int i = 0; i < 6; ++i) {
            const int id = i * NTHR + tid, cg = id & 15, rest = id >> 4, which = rest % 3, t = rest / 3;
            const int col = C_GQ + which * GDN_DIM + h * HD + cg * 8, wcol = which * GDN_DIM + h * HD + cg * 8;
            float acc[8];
#pragma unroll
            for (int e = 0; e < 8; ++e) acc[e] = 0.f;
#pragma unroll
            for (int tap = 0; tap < 4; ++tap) { const int tt = t - 3 + tap;
                if (n * 64 + tt >= 0) { float v[8]; unpack8(*(const v4u*)(PROJ + (size_t)(m0 + tt) * PQ + col), v);
                    const f32x4 w0 = *(const f32x4*)(convw + (size_t)tap * (3 * GDN_DIM) + wcol), w1 = *(const f32x4*)(convw + (size_t)tap * (3 * GDN_DIM) + wcol + 4);
                    acc[0] += w0.x * v[0]; acc[1] += w0.y * v[1]; acc[2] += w0.z * v[2]; acc[3] += w0.w * v[3]; acc[4] += w1.x * v[4]; acc[5] += w1.y * v[5]; acc[6] += w1.z * v[6]; acc[7] += w1.w * v[7]; } }
            float ss = 0.f;
#pragma unroll
            for (int e = 0; e < 8; ++e) { acc[e] = silu_f(acc[e]); ss += acc[e] * acc[e]; }
            ss += __shfl_xor(ss, 1); ss += __shfl_xor(ss, 2); ss += __shfl_xor(ss, 4); ss += __shfl_xor(ss, 8);
            const float beta = GT[64 + t], eg = GT[128 + t];
            if (which == 0) { const float rn = rsqrtf(ss + EPS) * 0.08838834764831845f;
#pragma unroll
                for (int e = 0; e < 8; ++e) acc[e] *= rn;
                *(LAS v4u*)(QB + t * 136 + cg * 8) = pack8(acc);
            } else if (which == 1) { const float rn = rsqrtf(ss + EPS);
#pragma unroll
                for (int e = 0; e < 8; ++e) acc[e] *= rn;
                *(LAS v4u*)(KB + t * 136 + cg * 8) = pack8(acc);
                const float sc = beta * eg;
                *(LAS f32x4*)(RHS + t * 256 + 128 + cg * 8) = (f32x4){acc[0] * sc, acc[1] * sc, acc[2] * sc, acc[3] * sc};
                *(LAS f32x4*)(RHS + t * 256 + 128 + cg * 8 + 4) = (f32x4){acc[4] * sc, acc[5] * sc, acc[6] * sc, acc[7] * sc};
            } else {
                *(LAS f32x4*)(RHS + t * 256 + cg * 8) = (f32x4){acc[0] * beta, acc[1] * beta, acc[2] * beta, acc[3] * beta};
                *(LAS f32x4*)(RHS + t * 256 + cg * 8 + 4) = (f32x4){acc[4] * beta, acc[5] * beta, acc[6] * beta, acc[7] * beta};
            }
        }
        WG_BAR();
        {
            const int mat = w >> 2, ti = w & 3, r16 = lane & 15, q4 = lane >> 4;
            const LAS bf16* Xb = mat ? QB : KB;
            bf16x8 xf[4];
#pragma unroll
            for (int ks = 0; ks < 4; ++ks) xf[ks] = *(const LAS bf16x8*)(Xb + (16 * ti + r16) * 136 + 32 * ks + 8 * q4);
            const int c = 16 * ti + r16; const float gc = GT[c], bc = GT[64 + c];
#pragma unroll
            for (int tj = 0; tj < 4; ++tj) {
                f32x4 acc = (f32x4){0.f, 0.f, 0.f, 0.f};
                if (tj <= ti) {
#pragma unroll
                    for (int ks = 0; ks < 4; ++ks) { const bf16x8 kf = *(const LAS bf16x8*)(KB + (16 * tj + r16) * 136 + 32 * ks + 8 * q4);
                        acc = __builtin_amdgcn_mfma_f32_16x16x32_bf16(kf, xf[ks], acc, 0, 0, 0); }
                }
                const int s0 = 16 * tj + 4 * q4; f32x4 o;
#pragma unroll
                for (int r = 0; r < 4; ++r) { const int s = s0 + r; const float dec = __expf(fminf(gc - GT[s], 0.f));
                    o[r] = mat ? (c >= s ? acc[r] * dec : 0.f) : (c > s ? bc * acc[r] * dec : 0.f); }
                if (mat) { u32x2 pk; pk.x = pk2(o[0], o[1]); pk.y = pk2(o[2], o[3]); *(u32x2*)(INTRA + (size_t)u * 4096 + c * 64 + s0) = pk; }
                else *(LAS f32x4*)(AL + c * 64 + s0) = o;
            }
        }
        WG_BAR();
        if (tid < 256) {
            const int j = tid; float xs[64];
#pragma unroll
            for (int i = 0; i < 64; ++i) xs[i] = RHS[i * 256 + j];
            int zoff; asm volatile("v_mov_b32 %0, 0" : "=v"(zoff));
            const LAS float* ALz = AL + zoff;
#pragma unroll
            for (int i = 1; i < 64; ++i) { float a = xs[i];
#pragma unroll
                for (int s4 = 0; s4 < (i + 3) / 4; ++s4) { const f32x4 av = *(const LAS f32x4*)(ALz + i * 64 + 4 * s4);
                    a -= av.x * xs[4 * s4]; a -= av.y * xs[4 * s4 + 1]; a -= av.z * xs[4 * s4 + 2]; a -= av.w * xs[4 * s4 + 3]; }
                xs[i] = a; }
            if (j < 128) { float* dst = UT + (size_t)u * 8192 + j * 64;
#pragma unroll
                for (int i = 0; i < 16; ++i) *(f32x4*)(dst + 4 * i) = (f32x4){xs[4 * i], xs[4 * i + 1], xs[4 * i + 2], xs[4 * i + 3]};
            } else { bf16* dst = NEGW + (size_t)u * 8192 + (j - 128);
#pragma unroll
                for (int i = 0; i < 64; ++i) dst[i * 128] = (bf16)f2bf(-xs[i]); }
        } else {
            const int tt = tid - 256; const float gl = GT[63];
#pragma unroll
            for (int it = 0; it < 4; ++it) { const int id = it * 256 + tt, t = id >> 4, c8 = id & 15; float v[8]; unpack8(*(const LAS v4u*)(QB + t * 136 + c8 * 8), v); const float eg = GT[128 + t];
#pragma unroll
                for (int e = 0; e < 8; ++e) v[e] *= eg;
                *(v4u*)(QDEC + (size_t)u * 8192 + t * 128 + c8 * 8) = pack8(v); }
#pragma unroll
            for (int it = 0; it < 4; ++it) { const int id = it * 256 + tt, dk = id & 127, tg = id >> 7; float v[8];
#pragma unroll
                for (int e = 0; e < 8; ++e) v[e] = bf2f(KB[(8 * tg + e) * 136 + dk]) * __expf(gl - GT[8 * tg + e]);
                *(v4u*)(KDT + (size_t)u * 8192 + dk * 64 + 8 * tg) = pack8(v); }
            if (tt == 0) EGL[u] = GT[128 + 63];
        }
        WG_BAR();
    }
}

constexpr int GS_NEGW = 0, GS_QDEC = 64 * 136 * 2, GS_INTRA = GS_QDEC + 64 * 136 * 2, GS_KDT = GS_INTRA + 64 * 72 * 2, GS_OB = GS_KDT + 128 * 72 * 2, GS_END = GS_OB + 64 * 132 * 4;
static_assert(GS_END <= RING_BYTES, "gdn scan LDS");
__device__ __forceinline__ bf16x8 frag2(const LAS bf16* p) { const u32x2 lo = *(const LAS u32x2*)p, hi = *(const LAS u32x2*)(p + 16); v4u w; w.x = lo.x; w.y = lo.y; w.z = hi.x; w.w = hi.y; return __builtin_bit_cast(bf16x8, w); }
__device__ __forceinline__ bf16x8 packacc(const f32x4 a, const f32x4 b) { v4u w; w.x = pg8::cvt_pk_bf16(a[0], a[1]); w.y = pg8::cvt_pk_bf16(a[2], a[3]); w.z = pg8::cvt_pk_bf16(b[0], b[1]); w.w = pg8::cvt_pk_bf16(b[2], b[3]); return __builtin_bit_cast(bf16x8, w); }
__device__ __forceinline__ void gdn_scan_phase(Frame& F, int layer) {
    bf16* const PROJ = WSP(bf16, WS_PROJ); bf16* const MIX = WSP(bf16, WS_MIX); bf16* const NEGW = WSP(bf16, WS_NEGW); bf16* const QDEC = WSP(bf16, WS_QDEC); bf16* const KDT = WSP(bf16, WS_KDT); bf16* const INTRA = WSP(bf16, WS_INTRA); float* const UT = WSP(float, WS_UT); float* const EGL = WSP(float, WS_EGL); const float* const g_ng = INP(9);
    LAS bf16* LN = (LAS bf16*)(F.lds + GS_NEGW); LAS bf16* LQ = (LAS bf16*)(F.lds + GS_QDEC); LAS bf16* LI = (LAS bf16*)(F.lds + GS_INTRA); LAS bf16* LK = (LAS bf16*)(F.lds + GS_KDT);
    LAS float* OB = (LAS float*)(F.lds + GS_OB);
    const int tid = F.tid, lane = F.lane, w = F.wave, r16 = lane & 15, q4 = lane >> 4;
    const float* ngain = g_ng + layer * HD;
    for (int bh = F.bx; bh < BATCH * NH; bh += F.G) {
        const int b = bh / NH, h = bh % NH;
        f32x4 Sacc[8]; bf16x8 Sb[4];
#pragma unroll
        for (int i = 0; i < 8; ++i) Sacc[i] = (f32x4){0.f, 0.f, 0.f, 0.f};
#pragma unroll
        for (int i = 0; i < 4; ++i) Sb[i] = (bf16x8){0, 0, 0, 0, 0, 0, 0, 0};
        v4u st[7]; f32x4 ut[4]; v4u zz[2]; float egl;
        const int tok = tid >> 3, part = tid & 7;
#define GS_LOAD(n_) do { const size_t u_ = (size_t)bh * 64 + (n_); \
            st[0] = *(const v4u*)(NEGW + u_ * 8192 + (size_t)tid * 8); st[1] = *(const v4u*)(NEGW + u_ * 8192 + (size_t)(tid + 512) * 8); \
            st[2] = *(const v4u*)(QDEC + u_ * 8192 + (size_t)tid * 8); st[3] = *(const v4u*)(QDEC + u_ * 8192 + (size_t)(tid + 512) * 8); \
            st[4] = *(const v4u*)(INTRA + u_ * 4096 + (size_t)tid * 8); \
            st[5] = *(const v4u*)(KDT + u_ * 8192 + (size_t)tid * 8); st[6] = *(const v4u*)(KDT + u_ * 8192 + (size_t)(tid + 512) * 8); \
            _Pragma("unroll") for (int mt_ = 0; mt_ < 4; ++mt_) ut[mt_] = *(const f32x4*)(UT + u_ * 8192 + (size_t)(16 * w + r16) * 64 + 16 * mt_ + 4 * q4); \
            const bf16* zp_ = PROJ + (size_t)(b * SEQ + (n_) * 64 + tok) * PQ + C_GZ + h * HD + 16 * part; zz[0] = *(const v4u*)zp_; zz[1] = *(const v4u*)(zp_ + 8); \
            egl = EGL[u_]; } while (0)
#define GS_STORE() do { \
            *(LAS v4u*)(LN + (tid >> 4) * 136 + (tid & 15) * 8) = st[0]; *(LAS v4u*)(LN + ((tid + 512) >> 4) * 136 + (tid & 15) * 8) = st[1]; \
            *(LAS v4u*)(LQ + (tid >> 4) * 136 + (tid & 15) * 8) = st[2]; *(LAS v4u*)(LQ + ((tid + 512) >> 4) * 136 + (tid & 15) * 8) = st[3]; \
            *(LAS v4u*)(LI + (tid >> 3) * 72 + (tid & 7) * 8) = st[4]; \
            *(LAS v4u*)(LK + (tid >> 3) * 72 + (tid & 7) * 8) = st[5]; *(LAS v4u*)(LK + ((tid + 512) >> 3) * 72 + (tid & 7) * 8) = st[6]; } while (0)
        GS_LOAD(0); GS_STORE();
        f32x4 utc[4]; v4u zc[2]; float eglc;
#pragma unroll
        for (int i = 0; i < 4; ++i) utc[i] = ut[i];
        zc[0] = zz[0]; zc[1] = zz[1]; eglc = egl;
        WG_BAR();
#pragma unroll 1
        for (int n = 0; n < NCHUNK; ++n) {
            if (n + 1 < NCHUNK) GS_LOAD(n + 1);
            f32x4 vacc[4];
#pragma unroll
            for (int mt = 0; mt < 4; ++mt) { vacc[mt] = utc[mt];
#pragma unroll
                for (int s = 0; s < 4; ++s) vacc[mt] = __builtin_amdgcn_mfma_f32_16x16x32_bf16(frag2(LN + (16 * mt + r16) * 136 + 32 * s + 4 * q4), Sb[s], vacc[mt], 0, 0, 0); }
            bf16x8 vb[2]; vb[0] = packacc(vacc[0], vacc[1]); vb[1] = packacc(vacc[2], vacc[3]);
            f32x4 oacc[4];
#pragma unroll
            for (int mt = 0; mt < 4; ++mt) { oacc[mt] = (f32x4){0.f, 0.f, 0.f, 0.f};
#pragma unroll
                for (int s = 0; s < 4; ++s) oacc[mt] = __builtin_amdgcn_mfma_f32_16x16x32_bf16(frag2(LQ + (16 * mt + r16) * 136 + 32 * s + 4 * q4), Sb[s], oacc[mt], 0, 0, 0);
#pragma unroll
                for (int s = 0; s < 2; ++s) oacc[mt] = __builtin_amdgcn_mfma_f32_16x16x32_bf16(frag2(LI + (16 * mt + r16) * 72 + 32 * s + 4 * q4), vb[s], oacc[mt], 0, 0, 0); }
#pragma unroll
            for (int m8 = 0; m8 < 8; ++m8) { Sacc[m8] = Sacc[m8] * eglc;
#pragma unroll
                for (int s = 0; s < 2; ++s) Sacc[m8] = __builtin_amdgcn_mfma_f32_16x16x32_bf16(frag2(LK + (16 * m8 + r16) * 72 + 32 * s + 4 * q4), vb[s], Sacc[m8], 0, 0, 0); }
#pragma unroll
            for (int s = 0; s < 4; ++s) Sb[s] = packacc(Sacc[2 * s], Sacc[2 * s + 1]);
#pragma unroll
            for (int mt = 0; mt < 4; ++mt)
#pragma unroll
                for (int r = 0; r < 4; ++r) OB[(16 * mt + 4 * q4 + r) * 132 + 16 * w + r16] = oacc[mt][r];
            WG_BAR();
            {
                float o[16]; float ss = 0.f;
#pragma unroll
                for (int i = 0; i < 4; ++i) { const f32x4 v = *(const LAS f32x4*)(OB + tok * 132 + 16 * part + 4 * i); o[4 * i] = v.x; o[4 * i + 1] = v.y; o[4 * i + 2] = v.z; o[4 * i + 3] = v.w; ss += (v.x * v.x + v.y * v.y) + (v.z * v.z + v.w * v.w); }
                ss += __shfl_xor(ss, 1); ss += __shfl_xor(ss, 2); ss += __shfl_xor(ss, 4);
                const float rn = rsqrtf(ss * (1.f / HD) + EPS);
                float z[16]; { float t8[8]; unpack8(zc[0], t8);
#pragma unroll
                    for (int e = 0; e < 8; ++e) z[e] = t8[e];
                    unpack8(zc[1], t8);
#pragma unroll
                    for (int e = 0; e < 8; ++e) z[8 + e] = t8[e]; }
                float r8[8];
                bf16* dst = MIX + (size_t)(b * SEQ + n * 64 + tok) * DM + POOL_DIM + ATTN_DIM + h * HD + 16 * part;
#pragma unroll
                for (int hf = 0; hf < 2; ++hf) {
#pragma unroll
                    for (int e = 0; e < 8; ++e) { const int d = 8 * hf + e; r8[e] = o[d] * rn * ngain[16 * part + d] * silu_f(z[d]); }
                    *(v4u*)(dst + 8 * hf) = pack8(r8); }
            }
            if (n + 1 < NCHUNK) { GS_STORE();
#pragma unroll
                for (int i = 0; i < 4; ++i) utc[i] = ut[i];
                zc[0] = zz[0]; zc[1] = zz[1]; eglc = egl; }
            WG_BAR();
        }
#undef GS_LOAD
#undef GS_STORE
    }
}

__device__ __forceinline__ fox::BlockRef fox_ref(Frame& F, int bh, int qb) {
    bf16* const PROJ = WSP(bf16, WS_PROJ); bf16* const MIX = WSP(bf16, WS_MIX); float* const NCK = WSP(float, WS_NCK);
    const int b = bh / NH, h = bh % NH; fox::BlockRef r;
    const bf16* base = PROJ + (size_t)(b * SEQ) * PQ + h * HD;
    r.Q = base + (size_t)(qb * fox::QB) * PQ + C_FQ; r.K = base + C_FK; r.V = base + C_FV;
    r.O = MIX + (size_t)(b * SEQ + qb * fox::QB) * DM + POOL_DIM + h * HD; r.NCK = NCK + (size_t)bh * SEQ; r.P0 = qb * fox::QB;
    return r;
}
__device__ __forceinline__ void fox_phase(Frame& F) {
    constexpr int NQB = SEQ / fox::QB, NX = NQB / 2, TOTAL = BATCH * NH * NX;
    int L = F.bx; if (L >= TOTAL) return;
    int bh = L / NX, x = L % NX, pass = 0;
    fox::BlockRef cur = fox_ref(F, bh, x);
    fox::Seam S;
    fox::fox_prime<PQ, DM>(cur, (fox::lchar*)F.lds, S);
    for (;;) {
        const bool more_pass = pass == 0, more_item = L + F.G < TOTAL, last = !more_pass && !more_item;
        int bhn = bh, xn = x, passn = pass + 1, Ln = L;
        if (!more_pass) { passn = 0; Ln = more_item ? L + F.G : L; bhn = Ln / NX; xn = Ln % NX; }
        const fox::BlockRef nxt = last ? cur : fox_ref(F, bhn, passn ? NQB - 1 - xn : xn);
        fox::fox_block<PQ, DM>(cur, nxt, (fox::lchar*)F.lds, S);
        if (last) break;
        cur = nxt; bh = bhn; x = xn; pass = passn; L = Ln;
    }
}

__device__ __forceinline__ void convgate_phase(Frame& F, int layer) {
    bf16* const U = WSP(bf16, WS_U); bf16* const ACT = WSP(bf16, WS_ACT); const float* const fconv_w = INP(13);
    constexpr int NCG = FFN / 8, RUN = 32, NRUN = M / RUN, NIT = NCG * NRUN;
    const float* cw = fconv_w + (size_t)layer * 3 * FFN2;
    for (int it = F.bx * NTHR + F.tid; it < NIT; it += F.G * NTHR) {
        const int cg = it % NCG, run = it / NCG, ch = cg * 8, p = ch >> 7, j = ch & 127, colg = 256 * p + j, colu = colg + 128;
        const int m0 = run * RUN, tseq0 = m0 & (SEQ - 1);
        float wg[3][8], wu[3][8];
#pragma unroll
        for (int tap = 0; tap < 3; ++tap) { const f32x4 a0 = *(const f32x4*)(cw + (size_t)tap * FFN2 + ch), a1 = *(const f32x4*)(cw + (size_t)tap * FFN2 + ch + 4), b0 = *(const f32x4*)(cw + (size_t)tap * FFN2 + FFN + ch), b1 = *(const f32x4*)(cw + (size_t)tap * FFN2 + FFN + ch + 4);
            wg[tap][0] = a0.x; wg[tap][1] = a0.y; wg[tap][2] = a0.z; wg[tap][3] = a0.w; wg[tap][4] = a1.x; wg[tap][5] = a1.y; wg[tap][6] = a1.z; wg[tap][7] = a1.w;
            wu[tap][0] = b0.x; wu[tap][1] = b0.y; wu[tap][2] = b0.z; wu[tap][3] = b0.w; wu[tap][4] = b1.x; wu[tap][5] = b1.y; wu[tap][6] = b1.z; wu[tap][7] = b1.w; }
        float g1[8], g2[8], u1[8], u2[8];
        const bf16* Ug = U + (size_t)m0 * FFN2 + colg; const bf16* Uu = U + (size_t)m0 * FFN2 + colu;
        if (tseq0 > 0) { unpack8(*(const v4u*)(Ug - FFN2), g1); unpack8(*(const v4u*)(Ug - 2 * FFN2), g2); unpack8(*(const v4u*)(Uu - FFN2), u1); unpack8(*(const v4u*)(Uu - 2 * FFN2), u2); }
        else {
#pragma unroll
            for (int e = 0; e < 8; ++e) { g1[e] = 0.f; g2[e] = 0.f; u1[e] = 0.f; u2[e] = 0.f; } }
        bf16* dst = ACT + (size_t)m0 * FFN + ch;
#pragma unroll 4
        for (int t = 0; t < RUN; ++t) { float gr[8], ur[8], o[8]; unpack8(*(const v4u*)(Ug + (size_t)t * FFN2), gr); unpack8(*(const v4u*)(Uu + (size_t)t * FFN2), ur);
#pragma unroll
            for (int e = 0; e < 8; ++e) { const float gc = wg[0][e] * g2[e] + wg[1][e] * g1[e] + wg[2][e] * gr[e], uc = wu[0][e] * u2[e] + wu[1][e] * u1[e] + wu[2][e] * ur[e];
                o[e] = silu_f(gc) * uc; g2[e] = g1[e]; g1[e] = gr[e]; u2[e] = u1[e]; u1[e] = ur[e]; }
            *(v4u*)(dst + (size_t)t * FFN) = pack8(o); }
    }
}
#ifndef MK_PER_PHASE
#define MK_PER_PHASE 1
#endif
constexpr int N_PHASES = 2 + 10 * DEPTH;
struct Args { const float* in[16]; float* out; unsigned char* ws; int ph_lo, ph_hi; };
static_assert(sizeof(Args) == 16 * 8 + 8 + 8 + 8, "Args has no padding");
__global__ void __launch_bounds__(NTHR, 2) hybrid_fwd(Args args) {
    extern __shared__ __attribute__((aligned(16))) unsigned char lds_raw[];
    Frame F;
    F.lds = (lptr)lds_raw;
    F.tid = threadIdx.x; F.lane = F.tid & 63; F.wave = __builtin_amdgcn_readfirstlane(F.tid >> 6); F.G = gridDim.x; F.bx = blockIdx.x; F.z = 0;
    F.ws = args.ws; F.ka = (const float* const __attribute__((address_space(4)))*)__builtin_amdgcn_kernarg_segment_ptr();
    for (int u = F.tid; u < (LDS_BYTES - LDSCTL_OFF) / 4; u += NTHR) ((LAS unsigned*)(F.lds + LDSCTL_OFF))[u] = 0u;
    __syncthreads();
    const int lo = args.ph_lo, hi = args.ph_hi;
    XcdBarrier bar; bar.bar = (unsigned*)(F.ws + WS_CTL) + CW_BAR; bar.x = 0; bar.st = nullptr;
    if (hi - lo > 1) bar = xcd_barrier_post((unsigned*)(F.ws + WS_CTL) + CW_BAR, (volatile LAS unsigned*)(F.lds + MISC_OFF) + 8);
#ifndef PHM
#define PHM 0xFFFF
#endif
#define IN(k) (lo <= (k) && (k) < hi)
#define EN(b) ((PHM >> (b)) & 1)
#define SEAM(k) do { if (IN(k) && IN((k) + 1)) xcd_barrier(bar); } while (0)

    if (EN(0) && IN(0)) { PHASE_LOCAL(); p0_prologue(F); SEAM(0); }
#pragma unroll 1
    for (int l = 0; l < DEPTH; ++l) {
        const int pb = 1 + 10 * l;
        if (EN(1) && IN(pb + 0)) { PHASE_LOCAL(); rms_rows_bf16(F, l == 0 ? INP(0) : WSP(float, WS_X), INP(1) + l * DM, WSP(bf16, WS_XN)); SEAM(pb + 0); }
        if (EN(2) && IN(pb + 1)) {
            PHASE_LOCAL(); pg8::Gemm g{WSP(bf16, WS_XN), WSP(bf16, WS_WIN) + (size_t)l * NPROJ * DM, M, NPROJ, DM}; pg8::StaticOrder S; S.init(M, NPROJ, F.G, F.bx);
            pg8::EpiProj E{WSP(bf16, WS_PROJ), PQ, WSP(float, WS_SMALL), PN_SMALL};
            pg8::gemm_phase<pg8::EpiProj, pg8::StaticOrder, true, true>(F.lds, g, S, E);
            SEAM(pb + 1);
        }
        if (EN(3) && IN(pb + 2)) { PHASE_LOCAL(); pool_phase(F, l); PHASE_LOCAL(); gdn_prep_phase(F, l); PHASE_LOCAL(); fox_cum_phase(F, l); SEAM(pb + 2); }
        if (EN(4) && IN(pb + 3)) { PHASE_LOCAL(); gdn_scan_phase(F, l); SEAM(pb + 3); }
        if (EN(5) && IN(pb + 4)) { PHASE_LOCAL(); fox_phase(F); SEAM(pb + 4); }
        if (EN(6) && IN(pb + 5)) {
            PHASE_LOCAL(); pg8::Gemm g{WSP(bf16, WS_MIX), WSP(bf16, WS_WO) + (size_t)l * DM * DM, M, DM, DM}; pg8::StaticOrder S; S.init(M, DM, F.G, F.bx);
            pg8::EpiResid E{l == 0 ? INP(0) : WSP(float, WS_X), WSP(float, WS_X), DM};
            pg8::gemm_phase<pg8::EpiResid, pg8::StaticOrder, true, true>(F.lds, g, S, E);
            SEAM(pb + 5);
        }
        if (EN(7) && IN(pb + 6)) { PHASE_LOCAL(); rms_rows_bf16(F, WSP(float, WS_X), INP(11) + l * DM, WSP(bf16, WS_XN)); SEAM(pb + 6); }
        if (EN(8) && IN(pb + 7)) {
            PHASE_LOCAL(); pg8::Gemm g{WSP(bf16, WS_XN), WSP(bf16, WS_WUP) + (size_t)l * FFN2 * DM, M, FFN2, DM}; pg8::StaticOrder S; S.init(M, FFN2, F.G, F.bx);
            pg8::EpiBf E{WSP(bf16, WS_U), FFN2};
            pg8::gemm_phase<pg8::EpiBf, pg8::StaticOrder, true, true>(F.lds, g, S, E);
            SEAM(pb + 7);
        }
        if (EN(9) && IN(pb + 8)) { PHASE_LOCAL(); convgate_phase(F, l); SEAM(pb + 8); }
        if (EN(10) && IN(pb + 9)) {
            PHASE_LOCAL(); pg8::Gemm g{WSP(bf16, WS_ACT), WSP(bf16, WS_WDN) + (size_t)l * DM * FFN, M, DM, FFN}; pg8::StaticOrder S; S.init(M, DM, F.G, F.bx);
            pg8::EpiResid E{WSP(float, WS_X), WSP(float, WS_X), DM};
            pg8::gemm_phase<pg8::EpiResid, pg8::StaticOrder, true, true>(F.lds, g, S, E);
            SEAM(pb + 9);
        }
    }
    if (EN(11) && IN(N_PHASES - 1)) { PHASE_LOCAL(); rms_rows_f32(F, WSP(float, WS_X), INP(15), (float*)F.ka[16 + F.z]); }
#undef IN
#undef SEAM
}

extern "C" void kernel_launch(void* const* d_in, const int* in_sizes, int n_in, void* d_out, int out_size, void* d_ws, size_t ws_size, hipStream_t stream) {
    static int grid = 0;
    if (grid == 0) {
        if (n_in != 16 || in_sizes[0] != M * DM || out_size != M * DM || ws_size < WS_END) { fprintf(stderr, "kernel_launch: shape/workspace mismatch (n_in %d, in0 %d, out %d, ws %zu, need %zu); nothing launched\n", n_in, n_in > 0 ? in_sizes[0] : -1, out_size, ws_size, (size_t)WS_END); grid = -1; return; }
        int dev = 0, cus = 0, per_cu = 0;
        if (hipGetDevice(&dev) != hipSuccess || hipDeviceGetAttribute(&cus, hipDeviceAttributeMultiprocessorCount, dev) != hipSuccess) { fprintf(stderr, "kernel_launch: device query failed\n"); grid = -1; return; }
        if (hipFuncSetAttribute((const void*)hybrid_fwd, hipFuncAttributeMaxDynamicSharedMemorySize, LDS_BYTES) != hipSuccess) { fprintf(stderr, "kernel_launch: hipFuncSetAttribute failed\n"); grid = -1; return; }
        if (hipOccupancyMaxActiveBlocksPerMultiprocessor(&per_cu, (const void*)hybrid_fwd, NTHR, LDS_BYTES) != hipSuccess || per_cu < 1) fprintf(stderr, "kernel_launch: note: occupancy query reports %d workgroups per CU\n", per_cu);
        (void)hipGetLastError();
        grid = cus;
    }
    if (grid < 0) return;
    if (hipMemsetAsync((char*)d_ws + WS_CTL, 0, CTL_ZERO_BYTES, stream) != hipSuccess) { fprintf(stderr, "kernel_launch: memset failed\n"); return; }
    Args a{};
    for (int i = 0; i < 16; ++i) a.in[i] = (const float*)d_in[i];
    a.out = (float*)d_out; a.ws = (unsigned char*)d_ws;
#if MK_PER_PHASE
    for (int p = 0; p < N_PHASES; ++p) { a.ph_lo = p; a.ph_hi = p + 1; hipLaunchKernelGGL(hybrid_fwd, dim3(grid), dim3(NTHR), LDS_BYTES, stream, a); }
#else
    a.ph_lo = 0; a.ph_hi = N_PHASES; hipLaunchKernelGGL(hybrid_fwd, dim3(grid), dim3(NTHR), LDS_BYTES, stream, a);
#endif
    const hipError_t le = hipPeekAtLastError();
    if (le != hipSuccess) fprintf(stderr, "kernel_launch: launch failed: %s\n", hipGetErrorName(le));
}
```

```cpp
#include <hip/hip_runtime.h>
#include <cstdio>
#include <cstdint>
#include <cstddef>
__device__ __forceinline__ int tid_local() { int t; asm volatile("v_mov_b32 %0, %1" : "=v"(t) : "v"(threadIdx.x)); return t; }
namespace pg8 {
#define PG8_LAS __attribute__((address_space(3)))
typedef unsigned short bf16_t;
typedef short bf16x8 __attribute__((ext_vector_type(8)));
typedef float f32x4 __attribute__((ext_vector_type(4)));
typedef unsigned u32x4 __attribute__((ext_vector_type(4)));
constexpr int BM = 256, BK = 64, HALF = 128, HTB = HALF * BK * 2  , STAGE_BYTES = 8 * HTB, RSL_OFF = STAGE_BYTES + 8192  , NXCD = 8, WGM = 4;

__host__ __device__ __forceinline__ int lds_byte(int r, int c) { const int st = (r >> 4) * 2 + (c >> 5), rr = r & 15, cc = c & 31, ob = rr * 64 + cc * 2; return st * 1024 + (ob ^ (((ob >> 9) & 1) << 5)); }
__host__ __device__ __forceinline__ void stage_rc(int b, int& R, int& C) { const int st = b / 1024, sb = b % 1024, swz = sb ^ (((sb >> 9) & 1) << 5); R = (st >> 1) * 16 + swz / 64; C = (st & 1) * 32 + (swz % 64) / 2; }
__host__ __device__ __forceinline__ int perm32(int rho) { const int n = rho >> 4, i = rho & 15; return 8 * (i >> 2) + 4 * n + (i & 3); }

struct Unit { int pm, pn; int par = 0; };
struct Gemm { const bf16_t* A; const bf16_t* Bt; int M, N, K; };

struct StaticOrder {
    int nM, nN, nwg, G, c, wgm;
    __host__ __device__ void init(int M, int N, int G_, int c_, int wgm_ = WGM) { nM = M / BM; nN = N / BM; nwg = nM * nN; G = G_; c = c_; wgm = wgm_; }
    __host__ __device__ bool next(int i, Unit& u) const {
        const long L = (long)i * G + c; if (L >= nwg) return false;
        int wgid = (int)L; { const int q = nwg / NXCD, r = nwg % NXCD, xcd = wgid % NXCD, off = wgid / NXCD; wgid = (xcd < r ? xcd * (q + 1) : r * (q + 1) + (xcd - r) * q) + off; }
        const int nig = wgm * nN, gid = wgid / nig, fm = gid * wgm, gsz = (nM - fm) < wgm ? (nM - fm) : wgm;
        u.pm = fm + ((wgid % nig) % gsz); u.pn = (wgid % nig) / gsz; return true;
    }
    __device__ __forceinline__ void a_ready(const Unit&) const {}
    __device__ __forceinline__ void done(const Unit&) const {}
};

typedef float f32x2_t __attribute__((ext_vector_type(2))); typedef __bf16 bf16x2_t __attribute__((ext_vector_type(2)));
__device__ __forceinline__ unsigned cvt_pk_bf16(float lo, float hi) { f32x2_t v = {lo, hi}; bf16x2_t b = __builtin_convertvector(v, bf16x2_t); return __builtin_bit_cast(unsigned, b); }
typedef float f32x2 __attribute__((ext_vector_type(2)));
__device__ __forceinline__ void rstd_rows(const float* rss, int row0, float inv_k, float eps, float (&rs)[2][4]) {
#pragma unroll
    for (int ai = 0; ai < 2; ++ai)
#pragma unroll
        for (int m = 0; m < 4; ++m) rs[ai][m] = __builtin_amdgcn_rsqf(rss[row0 + ai * HALF + m * 16] * inv_k + eps);
}
__device__ __forceinline__ void rstd_rows_lds(const PG8_LAS float* slot, int r, float inv_k, float eps, float (&rs)[2][4]) {
#pragma unroll
    for (int ai = 0; ai < 2; ++ai)
#pragma unroll
        for (int m = 0; m < 4; ++m) rs[ai][m] = __builtin_amdgcn_rsqf(slot[r + ai * HALF + m * 16] * inv_k + eps);
}
struct EpiProj {
    static constexpr bool PERM = true, AFTER_DRAIN = false, RSS_LDS = true;
    const PG8_LAS float* rsl;
    bf16_t* O; int ldc; float* small; int pn_small; const float* rss; float inv_k, eps; float* bnd;
    __device__ __forceinline__ void operator()(const f32x4 (&acc)[2][2][4][2], const Unit& u, int wr, int wc, int fr, int fq) const {
        const int row0 = u.pm * BM + wr * 64 + fr, col0 = u.pn * BM + wc * 32 + 8 * fq;
        float rs[2][4]; rstd_rows_lds(rsl + u.par * 256, wr * 64 + fr, inv_k, eps, rs);
        if (u.pn >= 4 && u.pn < 16) {
            float mx[2] = {0.f, 0.f};
#pragma unroll
            for (int ai = 0; ai < 2; ++ai)
#pragma unroll
                for (int m = 0; m < 4; ++m)
#pragma unroll
                    for (int bj = 0; bj < 2; ++bj) { const f32x4 v0 = acc[ai][bj][m][0] * rs[ai][m], v1 = acc[ai][bj][m][1] * rs[ai][m];
                        float ss = (v0[0] * v0[0] + v0[1] * v0[1]) + (v0[2] * v0[2] + v0[3] * v0[3]) + (v1[0] * v1[0] + v1[1] * v1[1]) + (v1[2] * v1[2] + v1[3] * v1[3]);
                        ss += __shfl_xor(ss, 16); ss += __shfl_xor(ss, 32);
                        mx[bj] = fmaxf(mx[bj], ss); }
#pragma unroll
            for (int bj = 0; bj < 2; ++bj) {
#pragma unroll
                for (int off = 1; off < 16; off <<= 1) mx[bj] = fmaxf(mx[bj], __shfl_xor(mx[bj], off));
                if (fr == 0 && fq == 0) (void)__hip_atomic_fetch_max((unsigned*)bnd + ((u.pm >> 4) * 24 + 2 * (u.pn - 4) + bj) * 4 + wc, __builtin_bit_cast(unsigned, mx[bj]), __ATOMIC_RELAXED, __HIP_MEMORY_SCOPE_AGENT); }
        }

        if (u.pn == pn_small) {
            if (wc < 2) {
#pragma unroll
                for (int ai = 0; ai < 2; ++ai)
#pragma unroll
                    for (int m = 0; m < 4; ++m) { float* sp = small + (size_t)(row0 + ai * HALF + m * 16) * 64 + wc * 32 + 8 * fq;
                        *(f32x4*)sp = acc[ai][0][m][0] * rs[ai][m]; *(f32x4*)(sp + 4) = acc[ai][0][m][1] * rs[ai][m]; }
            }
            return;
        }
#pragma unroll
        for (int ai = 0; ai < 2; ++ai)
#pragma unroll
            for (int m = 0; m < 4; ++m) { bf16_t* rowp = O + (size_t)(row0 + ai * HALF + m * 16) * ldc + col0;
#pragma unroll
                for (int bj = 0; bj < 2; ++bj) { const f32x4 v0 = acc[ai][bj][m][0] * rs[ai][m], v1 = acc[ai][bj][m][1] * rs[ai][m];
                    u32x4 w; w.x = cvt_pk_bf16(v0[0], v0[1]); w.y = cvt_pk_bf16(v0[2], v0[3]); w.z = cvt_pk_bf16(v1[0], v1[1]); w.w = cvt_pk_bf16(v1[2], v1[3]);
                    *(u32x4*)(rowp + bj * HALF) = w; } }
    }
};
struct EpiBf {
    static constexpr bool PERM = true, AFTER_DRAIN = false, RSS_LDS = false;
    bf16_t* O; int ldc;
    __device__ __forceinline__ void operator()(const f32x4 (&acc)[2][2][4][2], const Unit& u, int wr, int wc, int fr, int fq) const {
        const int row0 = u.pm * BM + wr * 64 + fr, col0 = u.pn * BM + wc * 32 + 8 * fq;
#pragma unroll
        for (int ai = 0; ai < 2; ++ai)
#pragma unroll
            for (int m = 0; m < 4; ++m) { bf16_t* rowp = O + (size_t)(row0 + ai * HALF + m * 16) * ldc + col0;
#pragma unroll
                for (int bj = 0; bj < 2; ++bj) { const f32x4 v0 = acc[ai][bj][m][0], v1 = acc[ai][bj][m][1];
                    u32x4 w; w.x = cvt_pk_bf16(v0[0], v0[1]); w.y = cvt_pk_bf16(v0[2], v0[3]); w.z = cvt_pk_bf16(v1[0], v1[1]); w.w = cvt_pk_bf16(v1[2], v1[3]);
                    *(u32x4*)(rowp + bj * HALF) = w; } }
    }
};
struct EpiResidStat {
    static constexpr bool PERM = false, AFTER_DRAIN = false, RSS_LDS = false;
    const float* base; float* out; int ldc; bf16_t* xb; float* rss;
    __device__ __forceinline__ void operator()(const f32x4 (&acc)[2][2][4][2], const Unit& u, int wr, int wc, int fr, int fq) const {
        const int col0 = u.pn * BM + wc * 32 + 4 * fq;
#pragma unroll
        for (int ai = 0; ai < 2; ++ai)
#pragma unroll
            for (int m = 0; m < 4; ++m) { const int row = u.pm * BM + ai * HALF + wr * 64 + m * 16 + fr; const size_t off = (size_t)row * ldc + col0; float ss = 0.f;
#pragma unroll
                for (int bj = 0; bj < 2; ++bj)
#pragma unroll
                    for (int n = 0; n < 2; ++n) { const f32x4 bs = *(const f32x4*)(base + off + bj * HALF + n * 16); const f32x4 o = bs + acc[ai][bj][m][n]; *(f32x4*)(out + off + bj * HALF + n * 16) = o;
                        unsigned long long pk = (unsigned long long)cvt_pk_bf16(o[0], o[1]) | ((unsigned long long)cvt_pk_bf16(o[2], o[3]) << 32); *(unsigned long long*)(xb + off + bj * HALF + n * 16) = pk;
                        ss += (o[0] * o[0] + o[1] * o[1]) + (o[2] * o[2] + o[3] * o[3]); }
                ss += __shfl_xor(ss, 16); ss += __shfl_xor(ss, 32);
                if (fq == 0) (void)__hip_atomic_fetch_add(rss + row, ss, __ATOMIC_RELAXED, __HIP_MEMORY_SCOPE_AGENT); }
    }
};
__device__ __forceinline__ float bf_lo(unsigned w) { return __builtin_bit_cast(float, w << 16); }
__device__ __forceinline__ float bf_hi(unsigned w) { return __builtin_bit_cast(float, w & 0xffff0000u); }
__device__ __forceinline__ void rowstat_add(float* rss, int row0, int fq, const float (&sv)[8]) {
#pragma unroll
    for (int t = 0; t < 2; ++t) { const float v = fq == 0 ? sv[t] : (fq == 1 ? sv[2 + t] : (fq == 2 ? sv[4 + t] : sv[6 + t])); const int blk = 2 * fq + t;
        (void)__hip_atomic_fetch_add(rss + row0 + (blk >> 2) * HALF + (blk & 3) * 16, v, __ATOMIC_RELAXED, __HIP_MEMORY_SCOPE_AGENT); }
}
struct EpiResidBfStat {
    static constexpr bool PERM = true, AFTER_DRAIN = false, RSS_LDS = false;
    bf16_t* xb; int ldc; float* rss;
    __device__ __forceinline__ void operator()(const f32x4 (&acc)[2][2][4][2], const Unit& u, int wr, int wc, int fr, int fq) const {
        const int row0 = u.pm * BM + wr * 64 + fr, col0 = u.pn * BM + wc * 32 + 8 * fq;
        float sv[8];
#pragma unroll
        for (int ai = 0; ai < 2; ++ai)
#pragma unroll
            for (int m = 0; m < 4; ++m) { const int row = row0 + ai * HALF + m * 16; bf16_t* rowp = xb + (size_t)row * ldc + col0; float ss = 0.f;
#pragma unroll
                for (int bj = 0; bj < 2; ++bj) { const u32x4 r = *(const u32x4*)(rowp + bj * HALF); f32x4 v0 = acc[ai][bj][m][0], v1 = acc[ai][bj][m][1];
                    v0[0] += bf_lo(r.x); v0[1] += bf_hi(r.x); v0[2] += bf_lo(r.y); v0[3] += bf_hi(r.y); v1[0] += bf_lo(r.z); v1[1] += bf_hi(r.z); v1[2] += bf_lo(r.w); v1[3] += bf_hi(r.w);
                    u32x4 w; w.x = cvt_pk_bf16(v0[0], v0[1]); w.y = cvt_pk_bf16(v0[2], v0[3]); w.z = cvt_pk_bf16(v1[0], v1[1]); w.w = cvt_pk_bf16(v1[2], v1[3]);
                    *(u32x4*)(rowp + bj * HALF) = w;
                    ss += ((v0[0] * v0[0] + v0[1] * v0[1]) + (v0[2] * v0[2] + v0[3] * v0[3])) + ((v1[0] * v1[0] + v1[1] * v1[1]) + (v1[2] * v1[2] + v1[3] * v1[3])); }
                ss += __shfl_xor(ss, 16); ss += __shfl_xor(ss, 32);
                sv[ai * 4 + m] = ss; }
        rowstat_add(rss, row0, fq, sv);
    }
};
struct EpiResidBfOut {
    static constexpr bool PERM = true, AFTER_DRAIN = false, RSS_LDS = false;
    const bf16_t* xb; float* out; int ldc;
    __device__ __forceinline__ void operator()(const f32x4 (&acc)[2][2][4][2], const Unit& u, int wr, int wc, int fr, int fq) const {
        const int row0 = u.pm * BM + wr * 64 + fr, col0 = u.pn * BM + wc * 32 + 8 * fq;
#pragma unroll
        for (int ai = 0; ai < 2; ++ai)
#pragma unroll
            for (int m = 0; m < 4; ++m) { const size_t off = (size_t)(row0 + ai * HALF + m * 16) * ldc + col0;
#pragma unroll
                for (int bj = 0; bj < 2; ++bj) { const u32x4 r = *(const u32x4*)(xb + off + bj * HALF); f32x4 v0 = acc[ai][bj][m][0], v1 = acc[ai][bj][m][1];
                    v0[0] += bf_lo(r.x); v0[1] += bf_hi(r.x); v0[2] += bf_lo(r.y); v0[3] += bf_hi(r.y); v1[0] += bf_lo(r.z); v1[1] += bf_hi(r.z); v1[2] += bf_lo(r.w); v1[3] += bf_hi(r.w);
                    *(f32x4*)(out + off + bj * HALF) = v0; *(f32x4*)(out + off + bj * HALF + 4) = v1; } }
    }
};
struct EpiFinalNorm {
    static constexpr bool PERM = true, AFTER_DRAIN = false, RSS_LDS = false;
    const bf16_t* xb; float* out; int ldc; float* rss; unsigned* cnt; const float* gain; float inv_k, eps; unsigned need;
    __device__ __forceinline__ void operator()(const f32x4 (&acc)[2][2][4][2], const Unit& u, int wr, int wc, int fr, int fq) const {
        const int row0 = u.pm * BM + wr * 64 + fr, col0 = u.pn * BM + wc * 32 + 8 * fq;
        float sv[8];
#pragma unroll
        for (int ai = 0; ai < 2; ++ai)
#pragma unroll
            for (int m = 0; m < 4; ++m) { const int row = row0 + ai * HALF + m * 16; const bf16_t* rowp = xb + (size_t)row * ldc + col0; float ss = 0.f;
#pragma unroll
                for (int bj = 0; bj < 2; ++bj) { const u32x4 r = *(const u32x4*)(rowp + bj * HALF); f32x4 v0 = acc[ai][bj][m][0], v1 = acc[ai][bj][m][1];
                    v0[0] += bf_lo(r.x); v0[1] += bf_hi(r.x); v0[2] += bf_lo(r.y); v0[3] += bf_hi(r.y); v1[0] += bf_lo(r.z); v1[1] += bf_hi(r.z); v1[2] += bf_lo(r.w); v1[3] += bf_hi(r.w);
                    ss += ((v0[0] * v0[0] + v0[1] * v0[1]) + (v0[2] * v0[2] + v0[3] * v0[3])) + ((v1[0] * v1[0] + v1[1] * v1[1]) + (v1[2] * v1[2] + v1[3] * v1[3])); }
                ss += __shfl_xor(ss, 16); ss += __shfl_xor(ss, 32);
                sv[ai * 4 + m] = ss; }
        rowstat_add(rss, row0, fq, sv);
        asm volatile("s_waitcnt vmcnt(0)\n\ts_barrier" ::: "memory");
        if (wr == 0 && wc == 0 && fr == 0 && fq == 0) {
            (void)__hip_atomic_fetch_add(cnt + u.pm, 1u, __ATOMIC_RELEASE, __HIP_MEMORY_SCOPE_AGENT);
            while (__hip_atomic_load(cnt + u.pm, __ATOMIC_ACQUIRE, __HIP_MEMORY_SCOPE_AGENT) < need) __builtin_amdgcn_s_sleep(1);
        }
        asm volatile("s_barrier" ::: "memory");
#pragma unroll
        for (int ai = 0; ai < 2; ++ai)
#pragma unroll
            for (int m = 0; m < 4; ++m) { const int row = row0 + ai * HALF + m * 16; const size_t off = (size_t)row * ldc + col0;
                const float rs = __builtin_amdgcn_rsqf(__hip_atomic_load(rss + row, __ATOMIC_RELAXED, __HIP_MEMORY_SCOPE_AGENT) * inv_k + eps);
#pragma unroll
                for (int bj = 0; bj < 2; ++bj) { const u32x4 r = *(const u32x4*)(xb + off + bj * HALF); f32x4 v0 = acc[ai][bj][m][0], v1 = acc[ai][bj][m][1];
                    v0[0] += bf_lo(r.x); v0[1] += bf_hi(r.x); v0[2] += bf_lo(r.y); v0[3] += bf_hi(r.y); v1[0] += bf_lo(r.z); v1[1] += bf_hi(r.z); v1[2] += bf_lo(r.w); v1[3] += bf_hi(r.w);
                    const f32x4 g0 = *(const f32x4*)(gain + col0 + bj * HALF), g1 = *(const f32x4*)(gain + col0 + bj * HALF + 4);
                    *(f32x4*)(out + off + bj * HALF) = v0 * rs * g0; *(f32x4*)(out + off + bj * HALF + 4) = v1 * rs * g1; } }
    }
};
struct EpiResid {
    static constexpr bool PERM = false, AFTER_DRAIN = false, RSS_LDS = false;
    const float* base; float* out; int ldc;
    __device__ __forceinline__ void operator()(const f32x4 (&acc)[2][2][4][2], const Unit& u, int wr, int wc, int fr, int fq) const {
        const int col0 = u.pn * BM + wc * 32 + 4 * fq;
#pragma unroll
        for (int ai = 0; ai < 2; ++ai)
#pragma unroll
            for (int m = 0; m < 4; ++m) { const size_t off = (size_t)(u.pm * BM + ai * HALF + wr * 64 + m * 16 + fr) * ldc + col0;
#pragma unroll
                for (int bj = 0; bj < 2; ++bj)
#pragma unroll
                    for (int n = 0; n < 2; ++n) { const f32x4 bs = *(const f32x4*)(base + off + bj * HALF + n * 16); *(f32x4*)(out + off + bj * HALF + n * 16) = bs + acc[ai][bj][m][n]; } }
    }
};
__device__ __forceinline__ float dpp_shr1(float oldv, float src) { return __builtin_bit_cast(float, __builtin_amdgcn_update_dpp(__builtin_bit_cast(int, oldv), __builtin_bit_cast(int, src), 0x111, 0xf, 0xf, false)); }
__device__ __forceinline__ float dpp_shr2(float oldv, float src) { return __builtin_bit_cast(float, __builtin_amdgcn_update_dpp(__builtin_bit_cast(int, oldv), __builtin_bit_cast(int, src), 0x112, 0xf, 0xf, false)); }
__device__ __forceinline__ float dpp_ror1(float src) { return __builtin_bit_cast(float, __builtin_amdgcn_mov_dpp(__builtin_bit_cast(int, src), 0x121, 0xf, 0xf, false)); }
__device__ __forceinline__ float dpp_ror2(float src) { return __builtin_bit_cast(float, __builtin_amdgcn_mov_dpp(__builtin_bit_cast(int, src), 0x122, 0xf, 0xf, false)); }
struct EpiConvGate {
    static constexpr bool PERM = true, AFTER_DRAIN = false, RSS_LDS = true;
    const PG8_LAS float* rsl;
    bf16_t* ACT; int ldact; const float* cw; int nch  ; float* HB; int npn; PG8_LAS float* halo;
    const float* rss; float inv_k, eps;
    __device__ __forceinline__ void operator()(const f32x4 (&acc)[2][2][4][2], const Unit& u, int wr, int wc, int fr, int fq) const {
        const int ch0 = u.pn * 128 + wc * 32 + 8 * fq;
        float rs[2][4]; rstd_rows_lds(rsl + u.par * 256, wr * 64 + fr, inv_k, eps, rs);
        int frh = fr, fqh = fq; asm volatile("" : "+v"(frh), "+v"(fqh));

        float wg[3][8], wu[3][8];
#pragma unroll
        for (int tap = 0; tap < 3; ++tap) { const f32x4 a0 = *(const f32x4*)(cw + (size_t)tap * 2 * nch + ch0), a1 = *(const f32x4*)(cw + (size_t)tap * 2 * nch + ch0 + 4), b0 = *(const f32x4*)(cw + (size_t)tap * 2 * nch + nch + ch0), b1 = *(const f32x4*)(cw + (size_t)tap * 2 * nch + nch + ch0 + 4);
            wg[tap][0] = a0[0]; wg[tap][1] = a0[1]; wg[tap][2] = a0[2]; wg[tap][3] = a0[3]; wg[tap][4] = a1[0]; wg[tap][5] = a1[1]; wg[tap][6] = a1[2]; wg[tap][7] = a1[3];
            wu[tap][0] = b0[0]; wu[tap][1] = b0[1]; wu[tap][2] = b0[2]; wu[tap][3] = b0[3]; wu[tap][4] = b1[0]; wu[tap][5] = b1[1]; wu[tap][6] = b1[2]; wu[tap][7] = b1[3]; }
        const int hcol = (wc * 4 + fq) * 8;
        if (fr >= 14) {
#pragma unroll
            for (int ai = 0; ai < 2; ++ai)
#pragma unroll
                for (int bj = 0; bj < 2; ++bj) { PG8_LAS float* hp = halo + (((2 * ai + wr) * 2 + (fr - 14)) * 2 + bj) * 128 + hcol;
                    *(PG8_LAS f32x4*)hp = acc[ai][bj][3][0] * rs[ai][3]; *(PG8_LAS f32x4*)(hp + 4) = acc[ai][bj][3][1] * rs[ai][3]; }
            if (wr == 1) { float* hb = HB + ((size_t)(u.pm * npn + u.pn) * 4 + 2 + (frh - 14)) * 256 + wc * 32 + 8 * fqh;
#pragma unroll
                for (int bj = 0; bj < 2; ++bj) { *(f32x4*)(hb + bj * 128) = acc[1][bj][3][0] * rs[1][3]; *(f32x4*)(hb + bj * 128 + 4) = acc[1][bj][3][1] * rs[1][3]; } }
        }
        if (fr < 2 && wr == 0) { float* hb = HB + ((size_t)(u.pm * npn + u.pn) * 4 + frh) * 256 + wc * 32 + 8 * fqh;
#pragma unroll
            for (int bj = 0; bj < 2; ++bj) { *(f32x4*)(hb + bj * 128) = acc[0][bj][0][0] * rs[0][0]; *(f32x4*)(hb + bj * 128 + 4) = acc[0][bj][0][1] * rs[0][0]; } }
        asm volatile("s_waitcnt lgkmcnt(0)\n\ts_barrier" ::: "memory");
#pragma unroll
        for (int ai = 0; ai < 2; ++ai) {
            const int seg = 2 * ai + wr;
            float p1o[2][8], p2o[2][8];
#pragma unroll
            for (int bj = 0; bj < 2; ++bj) {
                if (seg > 0) { const PG8_LAS float* h1 = halo + (((seg - 1) * 2 + 1) * 2 + bj) * 128 + hcol; const PG8_LAS float* h2 = halo + (((seg - 1) * 2 + (fr & 1)) * 2 + bj) * 128 + hcol;
                    const f32x4 a = *(const PG8_LAS f32x4*)h1, b = *(const PG8_LAS f32x4*)(h1 + 4), c = *(const PG8_LAS f32x4*)h2, d = *(const PG8_LAS f32x4*)(h2 + 4);
#pragma unroll
                    for (int i = 0; i < 4; ++i) { p1o[bj][i] = a[i]; p1o[bj][4 + i] = b[i]; p2o[bj][i] = c[i]; p2o[bj][4 + i] = d[i]; }
                } else {
#pragma unroll
                    for (int i = 0; i < 8; ++i) { p1o[bj][i] = 0.f; p2o[bj][i] = 0.f; } }
            }
#pragma unroll
            for (int m = 0; m < 4; ++m) {
                float o[8];
#pragma unroll
                for (int i = 0; i < 8; ++i) {
                    const float xg = acc[ai][0][m][i >> 2][i & 3] * rs[ai][m], xu = acc[ai][1][m][i >> 2][i & 3] * rs[ai][m];
                    float og1, og2, ou1, ou2;
                    if (m == 0) { og1 = p1o[0][i]; og2 = p2o[0][i]; ou1 = p1o[1][i]; ou2 = p2o[1][i]; }
                    else { const float pg = acc[ai][0][m - 1][i >> 2][i & 3] * rs[ai][m - 1], pu = acc[ai][1][m - 1][i >> 2][i & 3] * rs[ai][m - 1]; og1 = dpp_ror1(pg); og2 = dpp_ror2(pg); ou1 = dpp_ror1(pu); ou2 = dpp_ror2(pu); }
                    const float g1 = dpp_shr1(og1, xg), g2 = dpp_shr2(og2, xg), u1 = dpp_shr1(ou1, xu), u2 = dpp_shr2(ou2, xu);
                    const float gc = wg[0][i] * g2 + wg[1][i] * g1 + wg[2][i] * xg, uc = wu[0][i] * u2 + wu[1][i] * u1 + wu[2][i] * xu;
                    o[i] = gc * __builtin_amdgcn_rcpf(1.f + __expf(-gc)) * uc;
                }
                u32x4 w; w.x = cvt_pk_bf16(o[0], o[1]); w.y = cvt_pk_bf16(o[2], o[3]); w.z = cvt_pk_bf16(o[4], o[5]); w.w = cvt_pk_bf16(o[6], o[7]);
                *(u32x4*)(ACT + (size_t)(u.pm * BM + ai * HALF + wr * 64 + m * 16 + fr) * ldact + ch0) = w;
            }
        }
    }
};
template <class Epi, class Sched, bool ALIGN_EPI = false, bool SP2 = false>
__device__ __forceinline__ void gemm_phase(PG8_LAS unsigned char* lds, const Gemm g, const Sched& S, const Epi& E) {
    const int tid = tid_local(), wid = __builtin_amdgcn_readfirstlane(tid >> 6), lane = tid & 63, wr = wid >> 2, wc = wid & 3, fr = lane & 15, fq = lane >> 4;
    const int K = g.K, nt = K / BK;
    unsigned voffA[2], voffB[2];
#pragma unroll
    for (int i = 0; i < 2; ++i) { int R, C; stage_rc(tid * 16 + i * 8192, R, C); const int Rb = Epi::PERM ? ((R & ~31) + perm32(R & 31)) : R;
        voffA[i] = (unsigned)(R * K + C) * 2u; voffB[i] = (unsigned)(Rb * K + C) * 2u; }
    const size_t kstep = (size_t)(BK * 2);
    const size_t hstep = (size_t)HALF * K * 2;
    const size_t tstep = 2 * hstep;
    const unsigned ldsw = (unsigned)wid * 1024u;
    const int aoff = lds_byte(wr * 64 + fr, fq * 8), boff = lds_byte(wc * 32 + fr, fq * 8);
#define PG8_SA(b, h) (((b) * 2 + (h)) * HTB)
#define PG8_SB(b, h) ((4 + (b) * 2 + (h)) * HTB)
#define PG8_STAGE(bufoff, gbase, voff) do { _Pragma("unroll") for (int _i = 0; _i < 2; ++_i) \
        __builtin_amdgcn_global_load_lds((const unsigned*)((const char*)(gbase) + (voff)[_i]), (PG8_LAS unsigned*)(lds + (bufoff) + ldsw + _i * 8192), 16, 0, 0); } while (0)
#define PG8_LDA(dst, b, h) do { _Pragma("unroll") for (int m = 0; m < 4; ++m) _Pragma("unroll") for (int k = 0; k < 2; ++k) dst[m][k] = *(const PG8_LAS bf16x8*)(lds + PG8_SA(b, h) + aoff + m * 2048 + k * 1024); } while (0)
#define PG8_LDB(dst, b, h) do { _Pragma("unroll") for (int n = 0; n < 2; ++n) _Pragma("unroll") for (int k = 0; k < 2; ++k) dst[n][k] = *(const PG8_LAS bf16x8*)(lds + PG8_SB(b, h) + boff + n * 2048 + k * 1024); } while (0)
#define PG8_MMA(ai, bj, At, Bt) do { __builtin_amdgcn_s_setprio(1); _Pragma("unroll") for (int m = 0; m < 4; ++m) _Pragma("unroll") for (int n = 0; n < 2; ++n) _Pragma("unroll") for (int k = 0; k < 2; ++k) \
        acc[ai][bj][m][n] = __builtin_amdgcn_mfma_f32_16x16x32_bf16(Bt[n][k], At[m][k], acc[ai][bj][m][n], 0, 0, 0); __builtin_amdgcn_s_setprio(0); } while (0)
#define PG8_WAIT_V(n) asm volatile("s_waitcnt vmcnt(" #n ")" ::: "memory")
#define PG8_WAIT_L(n) asm volatile("s_waitcnt lgkmcnt(" #n ")" ::: "memory")
#define PG8_BAR __builtin_amdgcn_s_barrier()
#define PG8_SCHED __builtin_amdgcn_sched_barrier(0)
    Unit cur, nxt; int ui = 0;
    if (!S.next(0, cur)) return;
#define PG8_RSS_DMA(u_) do { if constexpr (Epi::RSS_LDS) { if (wid < 4) { const int t_ = tid_local(); __builtin_amdgcn_global_load_lds((const unsigned*)(E.rss + (u_).pm * BM + t_), (PG8_LAS unsigned*)(lds + RSL_OFF + (u_).par * 1024 + wid * 256), 4, 0, 0); } } } while (0)
    PG8_RSS_DMA(cur);
    f32x4 acc[2][2][4][2];
#pragma unroll
    for (int a = 0; a < 2; ++a)
#pragma unroll
        for (int b = 0; b < 2; ++b)
#pragma unroll
            for (int m = 0; m < 4; ++m)
#pragma unroll
                for (int n = 0; n < 2; ++n) acc[a][b][m][n] = (f32x4){0.f, 0.f, 0.f, 0.f};
    bf16x8 At[4][2], B0[2][2], B1[2][2];
    const char* cA = (const char*)g.A + (size_t)cur.pm * tstep; const char* cB = (const char*)g.Bt + (size_t)cur.pn * tstep;
    S.a_ready(cur);
    if constexpr (SP2) {
        PG8_STAGE(PG8_SB(0, 0), cB, voffB); PG8_STAGE(PG8_SB(0, 1), cB + hstep, voffB); PG8_STAGE(PG8_SA(0, 0), cA, voffA); PG8_STAGE(PG8_SA(0, 1), cA + hstep, voffA);
        if (wr == 1) PG8_BAR;
        PG8_WAIT_V(2); PG8_BAR;
        PG8_STAGE(PG8_SB(1, 0), cB + kstep, voffB); PG8_STAGE(PG8_SA(1, 0), cA + kstep, voffA); PG8_STAGE(PG8_SB(1, 1), cB + hstep + kstep, voffB);
        PG8_WAIT_V(6); PG8_BAR;
    } else {
        PG8_STAGE(PG8_SB(0, 0), cB, voffB); PG8_STAGE(PG8_SA(0, 0), cA, voffA); PG8_STAGE(PG8_SB(0, 1), cB + hstep, voffB); PG8_STAGE(PG8_SA(0, 1), cA + hstep, voffA);
        if (wr == 1) PG8_BAR;
        PG8_WAIT_V(4); PG8_BAR;
        PG8_STAGE(PG8_SB(1, 0), cB + kstep, voffB); PG8_STAGE(PG8_SA(1, 0), cA + kstep, voffA); PG8_STAGE(PG8_SB(1, 1), cB + hstep + kstep, voffB);
        PG8_WAIT_V(6); PG8_BAR;
    }
    for (;;) {
        const bool has_next = S.next(ui + 1, nxt);
        const char* nA = has_next ? (const char*)g.A + (size_t)nxt.pm * tstep : cA; const char* nB = has_next ? (const char*)g.Bt + (size_t)nxt.pn * tstep : cB;
        for (int t = 0; t < nt; t += 2) {
            const bool last = (t == nt - 2);
            const char* a1 = cA + (size_t)(t + 1) * kstep;
            const char* a2 = last ? nA : cA + (size_t)(t + 2) * kstep; const char* b2 = last ? nB : cB + (size_t)(t + 2) * kstep;
            const char* a3 = a2 + kstep; const char* b3 = b2 + kstep;
            if (last && has_next) S.a_ready(nxt);
            if constexpr (SP2) {
            PG8_LDB(B0, 0, 0); PG8_LDB(B1, 0, 1); PG8_SCHED; PG8_LDA(At, 0, 0); PG8_STAGE(PG8_SA(1, 1), a1 + hstep, voffA);
            PG8_WAIT_V(8); PG8_WAIT_L(0); PG8_BAR; PG8_MMA(0, 0, At, B0); PG8_MMA(0, 1, At, B1); PG8_BAR; PG8_SCHED;
            PG8_LDA(At, 0, 1); PG8_STAGE(PG8_SB(0, 0), b2, voffB); PG8_STAGE(PG8_SB(0, 1), b2 + hstep, voffB); PG8_STAGE(PG8_SA(0, 0), a2, voffA);
            PG8_WAIT_V(8); PG8_WAIT_L(0); PG8_BAR; PG8_MMA(1, 0, At, B0); PG8_MMA(1, 1, At, B1); PG8_BAR; PG8_SCHED;
            PG8_LDB(B0, 1, 0); PG8_LDB(B1, 1, 1); PG8_SCHED; PG8_LDA(At, 1, 0); PG8_STAGE(PG8_SA(0, 1), a2 + hstep, voffA);
            PG8_WAIT_V(8); PG8_WAIT_L(0); PG8_BAR; PG8_MMA(0, 0, At, B0); PG8_MMA(0, 1, At, B1); PG8_BAR; PG8_SCHED;
            PG8_LDA(At, 1, 1); PG8_STAGE(PG8_SB(1, 0), b3, voffB); PG8_STAGE(PG8_SB(1, 1), b3 + hstep, voffB); PG8_STAGE(PG8_SA(1, 0), a3, voffA);
            PG8_WAIT_V(8); PG8_WAIT_L(0); PG8_BAR; PG8_MMA(1, 0, At, B0); PG8_MMA(1, 1, At, B1); PG8_BAR; PG8_SCHED;
            } else {
            PG8_LDB(B0, 0, 0); PG8_SCHED; PG8_LDA(At, 0, 0); PG8_STAGE(PG8_SA(1, 1), a1 + hstep, voffA);
            PG8_WAIT_L(8); PG8_BAR; PG8_WAIT_L(0); PG8_MMA(0, 0, At, B0); PG8_BAR; PG8_SCHED;
            PG8_LDB(B1, 0, 1); PG8_STAGE(PG8_SB(0, 0), b2, voffB);
            PG8_BAR; PG8_WAIT_L(0); PG8_MMA(0, 1, At, B1); PG8_BAR;
            PG8_LDA(At, 0, 1); PG8_STAGE(PG8_SA(0, 0), a2, voffA);
            PG8_BAR; PG8_WAIT_L(0); PG8_MMA(1, 0, At, B0); PG8_BAR; PG8_SCHED;
            PG8_STAGE(PG8_SB(0, 1), b2 + hstep, voffB);
            PG8_WAIT_V(6); PG8_BAR; PG8_MMA(1, 1, At, B1); PG8_BAR;
            PG8_LDB(B0, 1, 0); PG8_SCHED; PG8_LDA(At, 1, 0); PG8_STAGE(PG8_SA(0, 1), a2 + hstep, voffA);
            PG8_WAIT_L(8); PG8_BAR; PG8_WAIT_L(0); PG8_MMA(0, 0, At, B0); PG8_BAR; PG8_SCHED;
            PG8_LDB(B1, 1, 1); PG8_STAGE(PG8_SB(1, 0), b3, voffB);
            PG8_BAR; PG8_WAIT_L(0); PG8_MMA(0, 1, At, B1); PG8_BAR;
            PG8_LDA(At, 1, 1); PG8_STAGE(PG8_SA(1, 0), a3, voffA);
            PG8_BAR; PG8_WAIT_L(0); PG8_MMA(1, 0, At, B0); PG8_BAR; PG8_SCHED;
            PG8_STAGE(PG8_SB(1, 1), b3 + hstep, voffB);
            PG8_WAIT_V(6); PG8_BAR; PG8_MMA(1, 1, At, B1); PG8_BAR;
            }
        }
        if constexpr (ALIGN_EPI) { if (wr == 0) PG8_BAR; }
        if constexpr (!Epi::AFTER_DRAIN) { E(acc, cur, wr, wc, fr, fq); S.done(cur); }
        if (!has_next) break;
#pragma unroll
        for (int a = 0; a < 2; ++a)
#pragma unroll
            for (int b = 0; b < 2; ++b)
#pragma unroll
                for (int m = 0; m < 4; ++m)
#pragma unroll
                    for (int n = 0; n < 2; ++n) acc[a][b][m][n] = (f32x4){0.f, 0.f, 0.f, 0.f};
        cur = nxt; cA = nA; cB = nB; ++ui; cur.par = ui & 1; PG8_RSS_DMA(cur);
        if constexpr (ALIGN_EPI) { if (wr == 1) PG8_BAR; }
    }
    PG8_WAIT_V(0);
    if constexpr (!ALIGN_EPI) { if (wr == 0) PG8_BAR; }
    PG8_BAR;
    if constexpr (Epi::AFTER_DRAIN) { E.fused(acc, cur, wr, wc, fr, fq, lds, wid, lane); S.done(cur); }
#undef PG8_SA
#undef PG8_SB
#undef PG8_STAGE
#undef PG8_LDA
#undef PG8_LDB
#undef PG8_MMA
#undef PG8_RSS_DMA
#undef PG8_WAIT_V
#undef PG8_WAIT_L
#undef PG8_BAR
#undef PG8_SCHED
}
}
constexpr int NWAVES = 8, NTHR = 512;
constexpr int BATCH = 4, SEQ = 4096, DM = 4096, M = BATCH * SEQ, DEPTH = 2;
constexpr int POOL_DIM = 1024, ATTN_DIM = 1536, GDN_DIM = 1536, NH = 12, HD = 128;
constexpr int IN_DIM = 11812, NPROJ = 12032  , PQ = 11776  ;
constexpr int FFN = 11008, FFN2 = 22016;
constexpr int C_POOL = 0, C_FQ = 1024, C_FK = 2560, C_FV = 4096, C_GQ = 5632, C_GK = 7168, C_GV = 8704, C_GZ = 10240, PN_SMALL = 46;
constexpr int SM_FF = 0, SM_GB = 12, SM_GA = 24;
constexpr float EPS = 1e-6f;
constexpr int NCHUNK = SEQ / 64;
constexpr int NUNIT_GDN = BATCH * NH * NCHUNK;

constexpr size_t MiB = 1u << 20;
constexpr size_t WS_CTL = 0, CTL_ZERO_BYTES = 1 * MiB, WS_RN2 = 1 * MiB;
constexpr size_t SZ_WIN = (size_t)NPROJ * DM * 2, SZ_WO = (size_t)DM * DM * 2, SZ_WUP = (size_t)FFN2 * DM * 2, SZ_WDN = (size_t)DM * FFN * 2, SZ_PW = (size_t)4 * 256 * 256 * 2;
constexpr size_t WS_WIN = 4 * MiB, WS_WO = WS_WIN + 2 * SZ_WIN, WS_WUP = WS_WO + 2 * SZ_WO, WS_WDN = WS_WUP + 2 * SZ_WUP, WS_PW = WS_WDN + 2 * SZ_WDN;
constexpr size_t WS_XN = ((WS_PW + 2 * SZ_PW + MiB - 1) / MiB) * MiB;
constexpr size_t WS_X = WS_XN + (size_t)M * DM * 2;
constexpr size_t WS_OV = WS_X + (size_t)M * DM * 4;
constexpr size_t WS_PROJ = WS_OV, WS_SMALL = WS_PROJ + (size_t)M * PQ * 2, WS_MIX = WS_SMALL + (size_t)M * 64 * 4;
constexpr size_t WS_NEGW = WS_MIX + (size_t)M * DM * 2;
constexpr size_t WS_QDEC = WS_NEGW + (size_t)NUNIT_GDN * 8192 * 2;
constexpr size_t WS_KDT = WS_QDEC + (size_t)NUNIT_GDN * 8192 * 2;
constexpr size_t WS_INTRA = WS_KDT + (size_t)NUNIT_GDN * 8192 * 2;
constexpr size_t WS_UT = WS_INTRA + (size_t)NUNIT_GDN * 4096 * 2;
constexpr size_t WS_EGL = WS_UT + (size_t)NUNIT_GDN * 8192 * 4;
constexpr size_t WS_NCK = WS_EGL + 16384;
constexpr size_t WS_OV_END1 = WS_NCK + (size_t)BATCH * NH * SEQ * 4;
constexpr size_t WS_U = WS_OV;
constexpr size_t WS_OV_END2 = WS_U + (size_t)M * FFN2 * 2;
constexpr size_t WS_ACT = ((((WS_OV_END1 > WS_OV_END2) ? WS_OV_END1 : WS_OV_END2) + MiB - 1) / MiB) * MiB;
constexpr size_t WS_HB = WS_ACT + (size_t)M * FFN * 2;
constexpr size_t WS_JLO = WS_HB + (size_t)(M / 256) * (FFN2 / 256) * 4 * 256 * 4;
constexpr size_t WS_END = WS_JLO + 4096;
static_assert(WS_END <= (size_t)2752 * MiB, "d_ws map exceeds the guaranteed workspace");

constexpr int CW_TMO = 0, CW_CODE = 1, CW_BAR = 4096, CW_Q = 8192, CW_BG = 8192 + 1024, CW_FN = 12288  , CW_BND = 13312  , CW_RS = 16384;

constexpr int RING_BYTES = 146432, LDSCTL_OFF = RING_BYTES, MISC_OFF = LDSCTL_OFF + 320, LDS_BYTES = 147456;
namespace fox {
typedef unsigned short bf16;
typedef short bf16x8 __attribute__((ext_vector_type(8)));
typedef short s16x4 __attribute__((ext_vector_type(4)));
typedef float f32x16 __attribute__((ext_vector_type(16)));
typedef float f32x4 __attribute__((ext_vector_type(4)));
typedef unsigned u32x4 __attribute__((ext_vector_type(4)));
typedef __attribute__((address_space(3))) char lchar;
constexpr int D = 128, NW = 8, QBLK = 32, KVBLK = 64, QB = NW * QBLK;
constexpr int SHM_V = KVBLK * D * 2, SHM_K = KVBLK * D * 2;
constexpr int OFF_WS = 2 * SHM_V + 2 * SHM_K, OFF_CK = OFF_WS + NW * 64 * 4, OFF_Q = OFF_CK + 2 * 64 * 4, LDS_BYTES = OFF_Q + NW * 8192;
constexpr float SCALE = 0.08838834764831845f;
constexpr float THR = 8.f;
#define FOX_KSWZ(row, colB) ((row) * 256 + ((colB) ^ (((row) & 7) << 4)))
#define FOX_SBAR() __builtin_amdgcn_sched_barrier(0)
__device__ __forceinline__ int v_st(int k, int c) { const int kk = (k & ~0xC) | ((k & 4) << 1) | ((k & 8) >> 1); return ((kk >> 3) * 4 + (c >> 5)) * 512 + ((kk & 7) * 32 + (c & 31)) * 2; }
__device__ __forceinline__ int v_rd_base(int lane) { return ((lane & 3) << 3) | (((lane >> 2) & 3) << 6) | (((lane >> 4) & 1) << 5) | (((lane >> 5) & 1) << 8); }
constexpr int v_rd_off(int d0, int ks, int half) { return d0 * 512 + ks * 4096 + half * 2048; }
__device__ __forceinline__ int crow(int r, int hi) { return (r & 3) + 8 * (r >> 2) + 4 * hi; }
__device__ __forceinline__ unsigned cvtpk(float lo, float hi) { return pg8::cvt_pk_bf16(lo, hi); }
__device__ __forceinline__ bf16x8 load8(const bf16* p) { return *reinterpret_cast<const bf16x8*>(p); }
__device__ __forceinline__ void mask_tile(f32x16& p0, f32x16& p1, int dq, unsigned W) {
    const float NEG = -__builtin_inff();
#pragma unroll
    for (int r = 0; r < 16; ++r) {
        const int c = (r & 3) + 8 * (r >> 2);
        if ((unsigned)(dq - c) >= W) p0[r] = NEG;
        if ((unsigned)(dq - c - 32) >= W) p1[r] = NEG;
    }
}
__device__ __forceinline__ void bias_tile(f32x16& p0, f32x16& p1, const lchar* ck, int hi) {
    const __attribute__((address_space(3))) float* c = (const __attribute__((address_space(3))) float*)ck + 4 * hi;
#pragma unroll
    for (int q = 0; q < 4; ++q) {
        const f32x4 a = *(const __attribute__((address_space(3))) f32x4*)(c + 8 * q), b = *(const __attribute__((address_space(3))) f32x4*)(c + 32 + 8 * q);
#pragma unroll
        for (int i = 0; i < 4; ++i) { p0[4 * q + i] += a[i]; p1[4 * q + i] += b[i]; }
    }
}
__device__ __forceinline__ void partialSM(f32x16& p0, f32x16& p1, float& m_reg, float& mn, float& alpha) {
    float pmax = p0[0];
#pragma unroll
    for (int r = 1; r < 16; ++r) pmax = fmaxf(pmax, p0[r]);
#pragma unroll
    for (int r = 0; r < 16; ++r) pmax = fmaxf(pmax, p1[r]);
    { auto rr = __builtin_amdgcn_permlane32_swap(__float_as_uint(pmax), __float_as_uint(pmax), false, false);
      pmax = fmaxf(__uint_as_float(rr[0]), __uint_as_float(rr[1])); }
    constexpr float C2 = 1.4426950408889634f * SCALE;
    if (__builtin_expect(__all((pmax - m_reg) * SCALE <= THR), 1)) { mn = m_reg; alpha = 1.f; }
    else { mn = fmaxf(m_reg, pmax); alpha = __builtin_amdgcn_exp2f((m_reg - mn) * C2); m_reg = mn; }
    const float mnL = -mn * C2;
#pragma unroll
    for (int r = 0; r < 16; ++r) p0[r] = fmaf(p0[r], C2, mnL);
#pragma unroll
    for (int r = 0; r < 16; ++r) p1[r] = fmaf(p1[r], C2, mnL);
#pragma unroll
    for (int r = 0; r < 16; ++r) p0[r] = __builtin_amdgcn_exp2f(p0[r]);
}
__device__ __forceinline__ void finishSM(f32x16& p0, f32x16& p1, float alpha, float& l_reg, bf16x8& pa0, bf16x8& pa1, bf16x8& pa2, bf16x8& pa3) {
#pragma unroll
    for (int r = 0; r < 16; ++r) p1[r] = __builtin_amdgcn_exp2f(p1[r]);
    float ps = 0;
#pragma unroll
    for (int r = 0; r < 16; ++r) ps += p0[r];
#pragma unroll
    for (int r = 0; r < 16; ++r) ps += p1[r];
    { auto rr = __builtin_amdgcn_permlane32_swap(__float_as_uint(ps), __float_as_uint(ps), false, false);
      ps = __uint_as_float(rr[0]) + __uint_as_float(rr[1]); }
    l_reg = l_reg * alpha + ps;
#define FOX_PK4(P, B_, OUT) do { unsigned a0 = cvtpk(P[B_+0], P[B_+1]), a1 = cvtpk(P[B_+2], P[B_+3]);                          \
        unsigned b0 = cvtpk(P[B_+4], P[B_+5]), b1 = cvtpk(P[B_+6], P[B_+7]);                                             \
        auto r0 = __builtin_amdgcn_permlane32_swap(a0, b0, false, false); auto r1 = __builtin_amdgcn_permlane32_swap(a1, b1, false, false); \
        u32x4 w = {r0[0], r1[0], r0[1], r1[1]}; OUT = __builtin_bit_cast(bf16x8, w); } while (0)
    FOX_PK4(p0, 0, pa0); FOX_PK4(p0, 8, pa1); FOX_PK4(p1, 0, pa2); FOX_PK4(p1, 8, pa3);
#undef FOX_PK4
}
template <int KB>
__device__ __forceinline__ void qkt(f32x16& p0, f32x16& p1, const lchar* K_lds, int r32, int hi, const lchar* qs) {
    p0 = f32x16{}; p1 = f32x16{};
    const lchar* kb[4];
#pragma unroll
    for (int dd = 0; dd < 4; ++dd) kb[dd] = K_lds + KB * SHM_K + FOX_KSWZ(r32, (dd * 16 + hi * 8) * 2);
#pragma unroll
    for (int d0 = 0; d0 < 8; ++d0) { const lchar* a = kb[d0 & 3] + (d0 >> 2) * 128;
        bf16x8 b0 = *reinterpret_cast<const __attribute__((address_space(3))) bf16x8*>(a);
        bf16x8 b1 = *reinterpret_cast<const __attribute__((address_space(3))) bf16x8*>(a + 32 * 256);
        const bf16x8 qf = *reinterpret_cast<const __attribute__((address_space(3))) bf16x8*>(qs + d0 * 1024);
        p0 = __builtin_amdgcn_mfma_f32_32x32x16_bf16(b0, qf, p0, 0, 0, 0);
        p1 = __builtin_amdgcn_mfma_f32_32x32x16_bf16(b1, qf, p1, 0, 0, 0); }
}
template <int VB>
__device__ __forceinline__ void pv_tile(f32x16* o, int vb0, bf16x8 pa0, bf16x8 pa1, bf16x8 pa2, bf16x8 pa3) {
#define FOX_TRRD(dst, off) asm volatile("ds_read_b64_tr_b16 %0, %1 offset:%2" : "=&v"(dst) : "v"(vb0), "i"(off) : "memory")
#define FOX_PV_D0(d0) do { s16x4 l0, l1, l2, l3, h0, h1, h2, h3; constexpr int b_ = VB * SHM_V + v_rd_off(d0, 0, 0); \
        FOX_TRRD(l0, b_); FOX_TRRD(h0, b_ + 2048); FOX_TRRD(l1, b_ + 4096); FOX_TRRD(h1, b_ + 6144); FOX_TRRD(l2, b_ + 8192); FOX_TRRD(h2, b_ + 10240); FOX_TRRD(l3, b_ + 12288); FOX_TRRD(h3, b_ + 14336); \
        asm volatile("s_waitcnt lgkmcnt(0)" ::: "memory"); FOX_SBAR();   \
        o[d0] = __builtin_amdgcn_mfma_f32_32x32x16_bf16(pa0, (bf16x8){l0[0], l0[1], l0[2], l0[3], h0[0], h0[1], h0[2], h0[3]}, o[d0], 0, 0, 0);   \
        o[d0] = __builtin_amdgcn_mfma_f32_32x32x16_bf16(pa1, (bf16x8){l1[0], l1[1], l1[2], l1[3], h1[0], h1[1], h1[2], h1[3]}, o[d0], 0, 0, 0);   \
        o[d0] = __builtin_amdgcn_mfma_f32_32x32x16_bf16(pa2, (bf16x8){l2[0], l2[1], l2[2], l2[3], h2[0], h2[1], h2[2], h2[3]}, o[d0], 0, 0, 0);   \
        o[d0] = __builtin_amdgcn_mfma_f32_32x32x16_bf16(pa3, (bf16x8){l3[0], l3[1], l3[2], l3[3], h3[0], h3[1], h3[2], h3[3]}, o[d0], 0, 0, 0); } while (0)
    FOX_PV_D0(0); FOX_PV_D0(1); FOX_PV_D0(2); FOX_PV_D0(3);
#undef FOX_PV_D0
#undef FOX_TRRD
}
struct BlockRef { const bf16* Q; const bf16* K; const bf16* V; bf16* O; const float* NCK; int P0; int jlo; };
struct Ctx { const bf16* PROJ; bf16* MIX; const float* NCK; unsigned* qc; unsigned first, end; __attribute__((address_space(3))) unsigned* slot; const __attribute__((address_space(3))) int* jl; };
__device__ __forceinline__ BlockRef item_ref(const Ctx& c, unsigned idx) {
    const unsigned a = idx - c.first; const int qb = (SEQ / QB - 1) - (int)(a / (unsigned)(BATCH * NH)), bh = (int)(a % (unsigned)(BATCH * NH)), b = bh / NH, h = bh % NH; BlockRef r;
    const bf16* base = c.PROJ + (size_t)(b * SEQ) * PQ + h * HD;
    r.Q = base + (size_t)(qb * QB) * PQ + C_FQ; r.K = base + C_FK; r.V = base + C_FV;
    r.O = c.MIX + (size_t)(b * SEQ + qb * QB) * DM + POOL_DIM + h * HD; r.NCK = c.NCK + (size_t)bh * SEQ; r.P0 = qb * QB; r.jlo = __builtin_amdgcn_readfirstlane(c.jl[bh * (SEQ / QB) + qb]);
    return r;
}
struct Seam { bf16x8 qr[8]; bf16x8 st_v0, st_v1, st_k0, st_k1; };
#define FOX_ROW(p, k0, rr) ((p) + (size_t)((k0) + (rr)) * PQ + sc)
#define FOX_VMW() asm volatile("s_waitcnt vmcnt(0)" ::: "memory")
#define FOX_VMWN(n) asm volatile("s_waitcnt vmcnt(%0)" :: "i"(n) : "memory")
#define FOX_SLOAD(Kp, Vp, Cp, k0, cb) do { S.st_v0 = load8(FOX_ROW(Vp, k0, sr)); S.st_v1 = load8(FOX_ROW(Vp, k0, 32 + sr));              \
                         S.st_k0 = load8(FOX_ROW(Kp, k0, sr)); S.st_k1 = load8(FOX_ROW(Kp, k0, 32 + sr)); \
                         if (wid == 0) __builtin_amdgcn_global_load_lds((const unsigned*)((Cp) + (k0) + lane), (__attribute__((address_space(3))) unsigned*)(CK_lds + (cb) * 64), 4, 0, 0); } while (0)
#define FOX_SWRITE_K(bf) do { *(__attribute__((address_space(3))) bf16x8*)(K_lds + (bf) * SHM_K + kws) = S.st_k0; *(__attribute__((address_space(3))) bf16x8*)(K_lds + (bf) * SHM_K + kws + 32 * 256) = S.st_k1; \
                              } while (0)
#define FOX_SWRITE_V(bf) do { *(__attribute__((address_space(3))) bf16x8*)(V_lds + (bf) * SHM_V + vst0) = S.st_v0; *(__attribute__((address_space(3))) bf16x8*)(V_lds + (bf) * SHM_V + vst1) = S.st_v1; } while (0)
#define FOX_SWRITE(bf) do { FOX_SWRITE_V(bf); FOX_SWRITE_K(bf); } while (0)
template <int PO>
__device__ __forceinline__ void fox_prime(const BlockRef& cur, lchar* lds, Seam& S) {
    const int tid = tid_local(), wid = __builtin_amdgcn_readfirstlane(tid >> 6), lane = tid & 63, r32 = lane & 31, hi = lane >> 5;
    const int sr = tid >> 4, sc = (tid & 15) * 8, kws = FOX_KSWZ(sr, sc * 2); lchar* K_lds = lds + 2 * SHM_V;
    __attribute__((address_space(3))) float* CK_lds = (__attribute__((address_space(3))) float*)(lds + OFF_CK);
#pragma unroll
    for (int d0 = 0; d0 < 8; ++d0) S.qr[d0] = load8(cur.Q + (size_t)(wid * QBLK + r32) * PQ + d0 * 16 + hi * 8);
    FOX_SLOAD(cur.K, cur.V, cur.NCK, cur.jlo * KVBLK, 0); FOX_VMW(); FOX_SWRITE_K(0);
    __syncthreads();
}
template <int PO>
__device__ __forceinline__ void fox_block(const BlockRef& cur, const Ctx& c, lchar* lds, Seam& S, unsigned& nidx) {
    const int tid = tid_local(), wid = __builtin_amdgcn_readfirstlane(tid >> 6), lane = tid & 63, r32 = lane & 31, hi = lane >> 5;
    constexpr unsigned W = 1u << 30;
    const int j_lo = cur.jlo, NT = (cur.P0 + QB - 1) / KVBLK + 1 - j_lo;
    const int qlo = cur.P0 + wid * QBLK, qm = qlo + r32 - 4 * hi;
    lchar* V_lds = lds; lchar* K_lds = lds + 2 * SHM_V;
    __attribute__((address_space(3))) float* ws = (__attribute__((address_space(3))) float*)(lds + OFF_WS) + wid * 64; __attribute__((address_space(3))) float* li_l = ws; __attribute__((address_space(3))) float* al_l = ws + 32;
    __attribute__((address_space(3))) float* CK_lds = (__attribute__((address_space(3))) float*)(lds + OFF_CK);
    float m_reg = -1e30f, l_reg = 0; f32x16 o[4] = {};
    const int sr = tid >> 4, sc = (tid & 15) * 8, vst0 = v_st(sr, sc), vst1 = v_st(32 + sr, sc), kws = FOX_KSWZ(sr, sc * 2);
    const int vb0 = (int)(unsigned)(uintptr_t)V_lds + v_rd_base(lane);
    const bf16* Kh = cur.K; const bf16* Vh = cur.V; const float* Ch = cur.NCK;
#define FOX_RESC(a) do { if (__any((a) < 1.f)) { if (hi == 0) al_l[r32] = (a); asm volatile("s_waitcnt lgkmcnt(0)" ::: "memory");              \
                     _Pragma("unroll") for (int d_ = 0; d_ < 4; ++d_) _Pragma("unroll") for (int r = 0; r < 16; ++r) o[d_][r] *= al_l[crow(r, hi)]; } } while (0)
#define FOX_KBASE(t) ((j_lo + (t)) * KVBLK)
#define FOX_MASKT(P0_, P1_, t, KB) do { const int kb_ = FOX_KBASE(t); bias_tile(P0_, P1_, (const lchar*)(CK_lds + (KB) * 64), hi); if (kb_ + KVBLK - 1 > qlo) mask_tile(P0_, P1_, qm - kb_, W); } while (0)
    constexpr int NQL = 8;
#define FOX_SEAM_K0() do { FOX_VMWN(NQL); FOX_SWRITE_K(0); FOX_SBAR(); } while (0)
    f32x16 pA0, pA1, pB0, pB1; float mnA, mnB, alA, alB; bf16x8 pa0, pa1, pa2, pa3;
    lchar* qs = lds + OFF_Q + wid * 8192 + lane * 16;
    FOX_VMW();
    unsigned nraw = 0u; if (tid == 0) nraw = __hip_atomic_fetch_add(c.qc, 1u, __ATOMIC_RELAXED, __HIP_MEMORY_SCOPE_AGENT);
#pragma unroll
    for (int d0 = 0; d0 < 8; ++d0) *reinterpret_cast<__attribute__((address_space(3))) bf16x8*>(qs + d0 * 1024) = S.qr[d0];
    FOX_SWRITE_V(0); FOX_SBAR();
    if (NT > 1) { FOX_SLOAD(Kh, Vh, Ch, FOX_KBASE(1), 1); }
    FOX_SBAR(); qkt<0>(pA0, pA1, K_lds, r32, hi, qs);
    FOX_MASKT(pA0, pA1, 0, 0); partialSM(pA0, pA1, m_reg, mnA, alA);
    if (NT > 1) { FOX_VMW(); FOX_SWRITE(1); }
    if (tid == 0) *c.slot = nraw;
    __syncthreads();
#define FOX_HALF_STEP(PX0, PX1, mnX, alX, PY0, PY1, alY, t, KB, VB, SB) do {                                                      \
        FOX_SBAR(); qkt<KB>(PX0, PX1, K_lds, r32, hi, qs);                                             \
        finishSM(PY0, PY1, alY, l_reg, pa0, pa1, pa2, pa3); FOX_SBAR();                                                           \
        if ((t) + 1 < NT) { FOX_SLOAD(Kh, Vh, Ch, FOX_KBASE((t) + 1), SB); FOX_SBAR(); }                                               \
        pv_tile<VB>(o, vb0, pa0, pa1, pa2, pa3); FOX_MASKT(PX0, PX1, (t), KB); partialSM(PX0, PX1, m_reg, mnX, alX);                                        \
        __syncthreads();                                                                                                      \
        if ((t) + 1 < NT) { FOX_VMW(); FOX_SWRITE(SB); }                                                                          \
        FOX_RESC(alX); __syncthreads(); } while (0)
    for (int t = 1; t + 1 < NT; t += 2) {
        FOX_HALF_STEP(pB0, pB1, mnB, alB, pA0, pA1, alA, t, 1, 0, 0);
        FOX_HALF_STEP(pA0, pA1, mnA, alA, pB0, pB1, alB, t + 1, 0, 1, 1);
    }
    const bool even = (NT & 1) == 0;
    if (even) { FOX_SBAR(); qkt<1>(pB0, pB1, K_lds, r32, hi, qs); FOX_SBAR(); }
    nidx = (unsigned)__builtin_amdgcn_readfirstlane((int)*c.slot);
    const BlockRef nxt = nidx < c.end ? item_ref(c, nidx) : cur;
    FOX_SLOAD(nxt.K, nxt.V, nxt.NCK, nxt.jlo * KVBLK, 0); FOX_SBAR();
#pragma unroll
    for (int d0 = 0; d0 < 8; ++d0) S.qr[d0] = load8(nxt.Q + (size_t)(wid * QBLK + r32) * PQ + d0 * 16 + hi * 8);
    FOX_SBAR();
    finishSM(pA0, pA1, alA, l_reg, pa0, pa1, pa2, pa3); FOX_SBAR();
    pv_tile<0>(o, vb0, pa0, pa1, pa2, pa3);
    if (even) { FOX_MASKT(pB0, pB1, NT - 1, 1); partialSM(pB0, pB1, m_reg, mnB, alB); __syncthreads(); FOX_RESC(alB);
        finishSM(pB0, pB1, alB, l_reg, pa0, pa1, pa2, pa3); FOX_SBAR(); pv_tile<1>(o, vb0, pa0, pa1, pa2, pa3); }
    FOX_SBAR(); FOX_SEAM_K0();
    if (hi == 0) li_l[r32] = l_reg; asm volatile("s_waitcnt lgkmcnt(0)" ::: "memory");
    float rli[16];
#pragma unroll
    for (int r = 0; r < 16; ++r) rli[r] = __builtin_amdgcn_rcpf(li_l[crow(r, hi)]);
    bf16* Ow = cur.O + (size_t)(wid * QBLK) * PO;
#pragma unroll
    for (int r = 0; r < 16; ++r) { const int orow = crow(r, hi);
#pragma unroll
        for (int d0 = 0; d0 < 4; ++d0) { const float v = o[d0][r] * rli[r];
            const float vn = __shfl_xor(v, 1);
            if ((r32 & 1) == 0) *(unsigned*)(Ow + (size_t)orow * PO + d0 * 32 + r32) = cvtpk(v, vn); } }
    __syncthreads();
#undef FOX_RESC
#undef FOX_KBASE
#undef FOX_MASKT
#undef FOX_SEAM_K0
#undef FOX_HALF_STEP
}
#undef FOX_ROW
#undef FOX_VMW
#undef FOX_VMWN
#undef FOX_SLOAD
#undef FOX_SWRITE_K
#undef FOX_SWRITE_V
#undef FOX_SWRITE
}
#define GAS __attribute__((address_space(1)))
#define LAS __attribute__((address_space(3)))
typedef unsigned short bf16;
typedef unsigned v4u __attribute__((ext_vector_type(4)));
typedef float f32x4 __attribute__((ext_vector_type(4)));
typedef short bf16x8 __attribute__((ext_vector_type(8)));
typedef GAS unsigned gu32;
typedef GAS unsigned long long gu64;
#define RLX_AGENT __ATOMIC_RELAXED, __HIP_MEMORY_SCOPE_AGENT
#define LDS_WAIT() asm volatile("s_waitcnt lgkmcnt(0)" ::: "memory")
#define VM_WAIT() asm volatile("s_waitcnt vmcnt(0)" ::: "memory")
__device__ __forceinline__ unsigned long long rt() { return __builtin_amdgcn_s_memrealtime(); }
__device__ __forceinline__ unsigned f2bf(float f) { unsigned u = __builtin_bit_cast(unsigned, f); return (u + 0x7fffu + ((u >> 16) & 1u)) >> 16; }
__device__ __forceinline__ unsigned pk2(float lo, float hi) { return f2bf(lo) | (f2bf(hi) << 16); }

#define XB_TMO      128
#define XB_XCNT(j)  (256  + 64 * (j))
#define XB_XSUB(j)  (1280 + 64 * (j))
#define XB_XGEN(j)  (2304 + 64 * (j))
#define XB_TOP      3328
#define XB_TOPGEN   3392
#define XCD_BAR_WORDS 3456
#define XB_SPIN_CAP (1u << 18)

__device__ __forceinline__ unsigned xb_ld(unsigned* p)              { return __hip_atomic_load(p, __ATOMIC_RELAXED, __HIP_MEMORY_SCOPE_AGENT); }
__device__ __forceinline__ unsigned xb_add(unsigned* p, unsigned v) { return __hip_atomic_fetch_add(p, v, __ATOMIC_RELAXED, __HIP_MEMORY_SCOPE_AGENT); }
__device__ __forceinline__ unsigned xb_xcc_id() { return (unsigned)__builtin_amdgcn_s_getreg((3 << 11) | 20) & 0xFu; }
#define XB_SPIN(cond, bar) do { unsigned _sp = 0; while (cond) { __builtin_amdgcn_s_sleep(1); \
    if ((++_sp & 255u) == 0u) { if (xb_ld(&(bar)[XB_TMO])) break; if (_sp > XB_SPIN_CAP) { atomicAdd(&(bar)[XB_TMO], 1u); break; } } } } while (0)

struct XcdBarrier {
    unsigned* bar; unsigned x;
    volatile LAS unsigned* st;
};

__device__ __forceinline__ XcdBarrier xcd_barrier_post(unsigned* bar, volatile LAS unsigned* st) {
    XcdBarrier b; b.bar = bar; b.x = xb_xcc_id(); b.st = st;
    if (threadIdx.x == 0) (void)xb_add(&bar[XB_XCNT(b.x)], 1u);
    return b;
}
__device__ __forceinline__ void xcd_barrier_complete(unsigned* bar, unsigned x, unsigned& nloc, unsigned& nx) {
    const unsigned G = gridDim.x * gridDim.y * gridDim.z;
    unsigned sum, cnt, mine, sp = 0u;
    for (;;) {
        sum = 0u; cnt = 0u; mine = 0u;
#pragma unroll
        for (unsigned j = 0; j < 16; ++j) { const unsigned c = xb_ld(&bar[XB_XCNT(j)]); sum += c; cnt += (c > 0u) ? 1u : 0u; mine = (j == x) ? c : mine; }
        if (sum == G) break;
        __builtin_amdgcn_s_sleep(1);
        if ((++sp & 255u) == 0u) { if (xb_ld(&bar[XB_TMO])) break; if (sp > XB_SPIN_CAP) { atomicAdd(&bar[XB_TMO], 1u); break; } }
    }
    nloc = mine > 0u ? mine : 1u; nx = cnt > 0u ? cnt : 1u;
}

__device__ __forceinline__ void xcd_barrier(const XcdBarrier& b) {
    asm volatile("s_waitcnt vmcnt(0)" ::: "memory");
    __syncthreads();
    if (threadIdx.x == 0) {
        unsigned* bar = b.bar;
        __builtin_amdgcn_s_waitcnt(0);
        unsigned nloc = b.st[0], nx = b.st[1];
        if (nloc == 0u) { xcd_barrier_complete(bar, b.x, nloc, nx); b.st[0] = nloc; b.st[1] = nx; }
        const unsigned old = xb_add(&bar[XB_XSUB(b.x)], 1u);
        const unsigned gen = old / nloc;
        if (old + 1u == (gen + 1u) * nloc) {
            __builtin_amdgcn_fence(__ATOMIC_RELEASE, "agent");
            asm volatile("s_waitcnt vmcnt(0)" ::: "memory");
            const unsigned og = xb_add(&bar[XB_TOP], 1u);
            const unsigned tg = og / nx;
            if (og + 1u == (tg + 1u) * nx) xb_add(&bar[XB_TOPGEN], 1u);
            else XB_SPIN(xb_ld(&bar[XB_TOPGEN]) == tg, bar);
            __builtin_amdgcn_fence(__ATOMIC_ACQUIRE, "agent");
            xb_add(&bar[XB_XGEN(b.x)], 1u);
            asm volatile("s_waitcnt vmcnt(0)" ::: "memory");
        } else {
            XB_SPIN(xb_ld(&bar[XB_XGEN(b.x)]) == gen, bar);
            __builtin_amdgcn_fence(__ATOMIC_ACQUIRE, "agent");
            asm volatile("s_waitcnt vmcnt(0)" ::: "memory");
        }
    }
    __syncthreads();
}

typedef unsigned u32x2 __attribute__((ext_vector_type(2)));
typedef float f32x2 __attribute__((ext_vector_type(2)));
typedef LAS unsigned char* lptr;
struct Frame {
    lptr lds; int tid, lane, wave, G, bx, z;
    unsigned char* ws; const float* const __attribute__((address_space(4)))* ka;
};
#define WSP(type, off) ((type*)(F.ws + (size_t)(off) + (size_t)(unsigned)F.z))
#define INP(k) ((const float*)F.ka[(k) + F.z])
#define PHASE_LOCAL() do { asm volatile("s_mov_b32 %0, 0" : "=s"(F.z)); F.tid = tid_local(); F.lane = F.tid & 63; F.wave = __builtin_amdgcn_readfirstlane(F.tid >> 6); } while (0)
__device__ __forceinline__ float bf2f(unsigned b) { return __builtin_bit_cast(float, b << 16); }
__device__ __forceinline__ float wave_sum(float v) {
#pragma unroll
    for (int o = 1; o < 64; o <<= 1) v += __shfl_xor(v, o);
    return v;
}
__device__ __forceinline__ void unpack8(const v4u w, float (&f)[8]) {
    f[0] = bf2f(w.x & 0xffffu); f[1] = __builtin_bit_cast(float, w.x & 0xffff0000u); f[2] = bf2f(w.y & 0xffffu); f[3] = __builtin_bit_cast(float, w.y & 0xffff0000u);
    f[4] = bf2f(w.z & 0xffffu); f[5] = __builtin_bit_cast(float, w.z & 0xffff0000u); f[6] = bf2f(w.w & 0xffffu); f[7] = __builtin_bit_cast(float, w.w & 0xffff0000u);
}
__device__ __forceinline__ v4u pack8(const float (&f)[8]) { v4u w; w.x = pk2(f[0], f[1]); w.y = pk2(f[2], f[3]); w.z = pk2(f[4], f[5]); w.w = pk2(f[6], f[7]); return w; }
__device__ __forceinline__ float silu_f(float x) { return x * __builtin_amdgcn_rcpf(1.f + __expf(-x)); }
__device__ __forceinline__ float softplus_f(float x) { return fmaxf(x, 0.f) + log1pf(__expf(-fabsf(x))); }
#define WG_BAR() __syncthreads()
#define LDS_BAR() asm volatile("s_waitcnt lgkmcnt(0)\n\ts_barrier" ::: "memory")

__device__ __forceinline__ int kperm(int k) { return (k & ~31) | ((k & 12) << 1) | ((k & 16) >> 2) | (k & 3); }

__device__ __forceinline__ void transpose_item(const float* W, int K, int Ns, bf16* WT, int kb, int nb, int srcc, int lane, const float* gain = nullptr) {
    const int kc = lane & 7, ng = lane >> 3, k0 = 64 * kb + 8 * kc, n0 = 32 * nb + 4 * ng;
    f32x4 v[8];
#pragma unroll
    for (int i = 0; i < 8; ++i) v[i] = srcc >= 0 ? *(const f32x4*)(W + (size_t)(k0 + i) * Ns + srcc) : (f32x4){0.f, 0.f, 0.f, 0.f};
    if (gain) { const f32x4 g0 = *(const f32x4*)(gain + k0), g1 = *(const f32x4*)(gain + k0 + 4);
#pragma unroll
        for (int i = 0; i < 4; ++i) { v[i] = v[i] * g0[i]; v[4 + i] = v[4 + i] * g1[i]; } }
#pragma unroll
    for (int j = 0; j < 4; ++j) { v4u o; o.x = pg8::cvt_pk_bf16(v[0][j], v[1][j]); o.y = pg8::cvt_pk_bf16(v[2][j], v[3][j]); o.z = pg8::cvt_pk_bf16(v[4][j], v[5][j]); o.w = pg8::cvt_pk_bf16(v[6][j], v[7][j]);
        *(v4u*)(WT + (size_t)(n0 + j) * K + k0) = o; }
}
__device__ __forceinline__ int map_win(int d) { return d < 5632 ? d : (d < 11776 ? d + 12 : (d < 11788 ? d - 6144 : (d < IN_DIM ? d : -1))); }
__device__ __forceinline__ int map_wup(int d) { const int p = d >> 8, j = d & 255; return j < 128 ? 128 * p + j : FFN + 128 * p + (j - 128); }
constexpr int CV_NB_IN = NPROJ / 32, CV_NB_O = DM / 32, CV_NB_UP = FFN2 / 32, CV_NB_DN = DM / 32;
constexpr int CV_I_IN = (DM / 64) * CV_NB_IN, CV_I_PW = 4 * 4 * 8, CV_I_O = (DM / 64) * CV_NB_O, CV_I_UP = (DM / 64) * CV_NB_UP, CV_I_DN = (FFN / 64) * CV_NB_DN;
constexpr int CV_NPER = CV_I_IN + CV_I_PW + CV_I_O + CV_I_UP + CV_I_DN;
constexpr int CV_W_IN = CV_I_IN + CV_I_PW, CV_W_O = CV_W_IN + CV_I_O, CV_W_UP = CV_W_O + CV_I_UP;
struct CvPtrs { const float *w_in, *pool_w, *w_o, *w_up, *w_down, *g_mix, *g_ffn; bf16 *WinT, *PWT, *WoT, *WupT, *WdnT; };
__device__ __forceinline__ void convert_item(const CvPtrs& P, int l, int r, int lane) {
    if (r < CV_I_IN) { const int kb = r / CV_NB_IN, nb = r % CV_NB_IN; transpose_item(P.w_in + (size_t)l * DM * IN_DIM, DM, IN_DIM, P.WinT + (size_t)l * NPROJ * DM, kb, nb, map_win(32 * nb + 4 * (lane >> 3)), lane, P.g_mix + l * DM); return; } r -= CV_I_IN;
    if (r < CV_I_PW) { const int g = r >> 5, kb = (r >> 3) & 3, nb = r & 7; transpose_item(P.pool_w + (size_t)(l * 4 + g) * 65536, 256, 256, P.PWT + (size_t)(l * 4 + g) * 65536, kb, nb, 32 * nb + 4 * (lane >> 3), lane); return; } r -= CV_I_PW;
    if (r < CV_I_O) { const int kb = r / CV_NB_O, nb = r % CV_NB_O; transpose_item(P.w_o + (size_t)l * DM * DM, DM, DM, P.WoT + (size_t)l * DM * DM, kb, nb, 32 * nb + 4 * (lane >> 3), lane); return; } r -= CV_I_O;
    if (r < CV_I_UP) { const int kb = r / CV_NB_UP, nb = r % CV_NB_UP; transpose_item(P.w_up + (size_t)l * DM * FFN2, DM, FFN2, P.WupT + (size_t)l * FFN2 * DM, kb, nb, map_wup(32 * nb + 4 * (lane >> 3)), lane, P.g_ffn + l * DM); return; } r -= CV_I_UP;
    { const int kb = r / CV_NB_DN, nb = r % CV_NB_DN; transpose_item(P.w_down + (size_t)l * FFN * DM, FFN, DM, P.WdnT + (size_t)l * DM * FFN, kb, nb, 32 * nb + 4 * (lane >> 3), lane); }
}
#define CV_PTRS() CvPtrs P; P.w_in = INP(2); P.pool_w = INP(3); P.w_o = INP(10); P.w_up = INP(12); P.w_down = INP(14); P.g_mix = INP(1); P.g_ffn = INP(11); \
    P.WinT = WSP(bf16, WS_WIN); P.PWT = WSP(bf16, WS_PW); P.WoT = WSP(bf16, WS_WO); P.WupT = WSP(bf16, WS_WUP); P.WdnT = WSP(bf16, WS_WDN)
__device__ __forceinline__ void p0_prologue(Frame& F) {
    CV_PTRS();
    const int gw = F.bx * NWAVES + F.wave, NGW = F.G * NWAVES, lane = F.lane;
    for (int it = gw; it < CV_NPER; it += NGW) convert_item(P, 0, it, lane);
}
__device__ __forceinline__ void bg_convert(Frame& F, int quota_chunks, int watermark) {
    CV_PTRS();
    unsigned* qc = (unsigned*)(F.ws + WS_CTL) + CW_BG; const int lane = F.lane, w = F.wave;
    LAS unsigned* slot = (LAS unsigned*)(F.lds + MISC_OFF + 96);
    for (int done = 0; done < quota_chunks; ++done) {
        if (F.tid == 0) { unsigned v = 0xffffffffu; if ((int)__hip_atomic_load(qc, __ATOMIC_RELAXED, __HIP_MEMORY_SCOPE_AGENT) < watermark) v = __hip_atomic_fetch_add(qc, 64u, __ATOMIC_RELAXED, __HIP_MEMORY_SCOPE_AGENT); *slot = v; }
        __syncthreads(); const unsigned base = (unsigned)__builtin_amdgcn_readfirstlane((int)*slot); __syncthreads();
        if (base >= (unsigned)CV_NPER) break;
#pragma unroll 1
        for (int k = 0; k < 8; ++k) { const unsigned idx = base + 8u * k + (unsigned)w; if (idx < (unsigned)CV_NPER) convert_item(P, 1, (int)idx, lane); }
    }
}

__device__ __forceinline__ void rms_rows_bf16(Frame& F, const float* X, const float* gain, bf16* O) {
    const int gw = F.bx * NWAVES + F.wave, NGW = F.G * NWAVES;
    for (int m = gw; m < M; m += NGW) {
        const f32x4* xr = (const f32x4*)(X + (size_t)m * DM) + F.lane; const f32x4* gr = (const f32x4*)gain + F.lane;
        f32x4 v[16]; float s = 0.f;
#pragma unroll
        for (int j = 0; j < 16; ++j) { v[j] = xr[64 * j]; s += (v[j].x * v[j].x + v[j].y * v[j].y) + (v[j].z * v[j].z + v[j].w * v[j].w); }
        const float r = rsqrtf(wave_sum(s) * (1.f / DM) + EPS);
        unsigned long long* o8 = (unsigned long long*)(O + (size_t)m * DM) + F.lane;
#pragma unroll
        for (int j = 0; j < 16; ++j) { const f32x4 g = gr[64 * j]; o8[64 * j] = (unsigned long long)pk2(v[j].x * r * g.x, v[j].y * r * g.y) | ((unsigned long long)pk2(v[j].z * r * g.z, v[j].w * r * g.w) << 32); }
    }
}
__device__ __forceinline__ void cast_rows_stat(Frame& F, const float* X, bf16* O, float* rss) {
    const int gw = F.bx * NWAVES + F.wave, NGW = F.G * NWAVES;
    for (int m = gw; m < M; m += NGW) {
        const f32x4* xr = (const f32x4*)(X + (size_t)m * DM) + F.lane;
        f32x4 v[16]; float s = 0.f;
#pragma unroll
        for (int j = 0; j < 16; ++j) { v[j] = xr[64 * j]; }
        unsigned long long* o8 = (unsigned long long*)(O + (size_t)m * DM) + F.lane;
#pragma unroll
        for (int j = 0; j < 16; ++j) { s += (v[j].x * v[j].x + v[j].y * v[j].y) + (v[j].z * v[j].z + v[j].w * v[j].w); o8[64 * j] = (unsigned long long)pk2(v[j].x, v[j].y) | ((unsigned long long)pk2(v[j].z, v[j].w) << 32); }
        s = wave_sum(s);
        if (F.lane == 0) rss[m] = s;
    }
}
__device__ __forceinline__ void rms_rows_f32(Frame& F, const float* X, const float* gain, float* O) {
    const int gw = F.bx * NWAVES + F.wave, NGW = F.G * NWAVES;
    for (int m = gw; m < M; m += NGW) {
        const f32x4* xr = (const f32x4*)(X + (size_t)m * DM) + F.lane; const f32x4* gr = (const f32x4*)gain + F.lane;
        f32x4 v[16]; float s = 0.f;
#pragma unroll
        for (int j = 0; j < 16; ++j) { v[j] = xr[64 * j]; s += (v[j].x * v[j].x + v[j].y * v[j].y) + (v[j].z * v[j].z + v[j].w * v[j].w); }
        const float r = rsqrtf(wave_sum(s) * (1.f / DM) + EPS);
        f32x4* o = (f32x4*)(O + (size_t)m * DM) + F.lane;
#pragma unroll
        for (int j = 0; j < 16; ++j) { const f32x4 g = gr[64 * j]; o[64 * j] = v[j] * r * g; }
    }
}

template <int WIN>
__device__ __forceinline__ void pool_stage1(const bf16* src, int tseq0, int t0, LAS bf16* Prow  ) {
    constexpr int NR = WIN + 3; v4u r[NR];
#pragma unroll
    for (int i = 0; i < NR; ++i) { const int j = t0 - (WIN - 1) + i; r[i] = (tseq0 + j >= 0) ? *(const v4u*)(src + (ptrdiff_t)j * PQ) : (v4u){0u, 0u, 0u, 0u}; }
    float s[8];
#pragma unroll
    for (int e = 0; e < 8; ++e) s[e] = 0.f;
#pragma unroll
    for (int i = 0; i < WIN - 1; ++i) { float v[8]; unpack8(r[i], v);
#pragma unroll
        for (int e = 0; e < 8; ++e) s[e] += v[e]; }
#pragma unroll
    for (int i = 0; i < 4; ++i) { const int t = t0 + i; float cur[8]; unpack8(r[WIN - 1 + i], cur);
#pragma unroll
        for (int e = 0; e < 8; ++e) s[e] += cur[e];
        const int pos = tseq0 + t + 1; const float inv = 1.f / (float)(pos < WIN ? pos : WIN); float o[8];
#pragma unroll
        for (int e = 0; e < 8; ++e) o[e] = s[e] * inv - cur[e];
        *(LAS v4u*)(Prow + t * 264) = pack8(o);
        float old[8]; unpack8(r[i], old);
#pragma unroll
        for (int e = 0; e < 8; ++e) s[e] -= old[e]; }
}
__device__ __forceinline__ void pool_unit(Frame& F, int layer, const int u) {
    bf16* const PWT = WSP(bf16, WS_PW); bf16* const PROJ = WSP(bf16, WS_PROJ); bf16* const MIX = WSP(bf16, WS_MIX); const float* const pool_scale = INP(4);
    LAS bf16* P = (LAS bf16*)F.lds;
    constexpr int PST = 264;
    const bf16* PW = PWT + (size_t)layer * 4 * 65536; const float* scale = pool_scale + layer * POOL_DIM;
    const int tid = F.tid, lane = F.lane, w = F.wave, r16 = lane & 15, q4 = lane >> 4;
    {
        const int tile = u >> 2, g = u & 3, m0 = tile * 64, tseq0 = m0 & (SEQ - 1);
        {
            const int c8 = tid & 31, t0 = 4 * (tid >> 5);
            const bf16* src = PROJ + (size_t)m0 * PQ + C_POOL + g * 256 + c8 * 8;
            if (g == 0) pool_stage1<2>(src, tseq0, t0, P + c8 * 8); else if (g == 1) pool_stage1<4>(src, tseq0, t0, P + c8 * 8);
            else if (g == 2) pool_stage1<8>(src, tseq0, t0, P + c8 * 8); else pool_stage1<16>(src, tseq0, t0, P + c8 * 8);
        }
        bf16x8 wf[8][2];
#pragma unroll
        for (int ks = 0; ks < 8; ++ks)
#pragma unroll
            for (int ne = 0; ne < 2; ++ne) wf[ks][ne] = *(const bf16x8*)(PW + (size_t)(g * 256 + 32 * w + 16 * ne + r16) * 256 + 32 * ks + 8 * q4);
        LDS_BAR();
        {
            f32x4 acc[2][4];
#pragma unroll
            for (int a = 0; a < 2; ++a)
#pragma unroll
                for (int bq = 0; bq < 4; ++bq) acc[a][bq] = (f32x4){0.f, 0.f, 0.f, 0.f};
#pragma unroll
            for (int ks = 0; ks < 8; ++ks) {
                bf16x8 pf[4];
#pragma unroll
                for (int tt = 0; tt < 4; ++tt) pf[tt] = *(const LAS bf16x8*)(P + (16 * tt + r16) * PST + 32 * ks + 8 * q4);
#pragma unroll
                for (int ne = 0; ne < 2; ++ne)
#pragma unroll
                    for (int tt = 0; tt < 4; ++tt) acc[ne][tt] = __builtin_amdgcn_mfma_f32_16x16x32_bf16(wf[ks][ne], pf[tt], acc[ne][tt], 0, 0, 0);
            }
#pragma unroll
            for (int ne = 0; ne < 2; ++ne) { const int e = 32 * w + 16 * ne + 4 * q4; const f32x4 sc = *(const f32x4*)(scale + g * 256 + e);
#pragma unroll
                for (int tt = 0; tt < 4; ++tt) { const int t = 16 * tt + r16; const f32x4 v = acc[ne][tt] * sc;
                    u32x2 o; o.x = pk2(v.x, v.y); o.y = pk2(v.z, v.w);
                    *(u32x2*)(MIX + (size_t)(m0 + t) * DM + g * 256 + e) = o; } }
        }
        LDS_BAR();
    }
}

__device__ __forceinline__ void fox_cum_phase(Frame& F, int layer) {
    float* const SMALL = WSP(float, WS_SMALL); float* const NCK = WSP(float, WS_NCK); const float* const fox_bias = INP(5); const float* const BND = (const float*)(F.ws + WS_CTL) + CW_BND + layer * (BATCH * 24 * 4); int* const JLO = WSP(int, WS_JLO);
    LAS float* WT = (LAS float*)F.lds;
    LAS float* TE = WT + 32; LAS float* BS = WT + 96;
    const int lane = F.lane, w = F.wave;
    for (int bh = F.bx; bh < BATCH * NH; bh += F.G) {
        const int b = bh / NH, h = bh % NH; const float fb = fox_bias[layer * NH + h];
        const int t0 = 512 * w + 8 * lane;
        const float* src = SMALL + (size_t)(b * SEQ + t0) * 64 + SM_FF + h;
        float lf[8];
#pragma unroll
        for (int i = 0; i < 8; ++i) lf[i] = src[(size_t)i * 64];
        float s = 0.f;
#pragma unroll
        for (int i = 0; i < 8; ++i) { const float xx = lf[i] + fb; s += fminf(xx, 0.f) - log1pf(__expf(-fabsf(xx))); lf[i] = s; }
        float inc = s;
#pragma unroll
        for (int off = 1; off < 64; off <<= 1) { const float v = __shfl_up(inc, off); if (lane >= off) inc += v; }
        if (lane == 63) WT[w] = inc;
        LDS_BAR();
        float base = inc - s;
        for (int k = 0; k < w; ++k) base += WT[k];
        float nck[8];
#pragma unroll
        for (int i = 0; i < 8; ++i) nck[i] = -(base + lf[i]) * 11.313708498984761f;
        float* dst = NCK + (size_t)bh * SEQ + t0;
        *(f32x4*)dst = (f32x4){nck[0], nck[1], nck[2], nck[3]}; *(f32x4*)(dst + 4) = (f32x4){nck[4], nck[5], nck[6], nck[7]};
        if ((t0 & 63) == 56) TE[t0 >> 6] = nck[7];
        if ((t0 & 255) == 0) BS[t0 >> 8] = nck[0];
        LDS_BAR();
        if (F.tid < SEQ / 256) {
            const f32x4 bq = *(const f32x4*)(BND + (b * 24 + h) * 4), bk = *(const f32x4*)(BND + (b * 24 + 12 + h) * 4);
            const float qm = (bq[0] + bq[1]) + (bq[2] + bq[3]), km = (bk[0] + bk[1]) + (bk[2] + bk[3]);
            const float bound = 2.04f * sqrtf(qm * km) + 115.f * 11.313708498984761f;
            const int qb = F.tid; const float bs = BS[qb]; int jl = 0;
            for (int j = 0; j < 4 * qb; ++j) jl += (bs - TE[j] > bound) ? 1 : 0;
            JLO[bh * (SEQ / 256) + qb] = jl;
        }
        LDS_BAR();
    }
}

constexpr int GP_RT = 0, GP_RT_SZ = 64 * 264 * 2, GP_AL = GP_RT + 2 * GP_RT_SZ, GP_AL_SZ = 64 * 64 * 4, GP_GT = GP_AL + 2 * GP_AL_SZ, GP_GT_SZ = 1024, GP_KB = GP_GT + 2 * GP_GT_SZ, GP_QB = GP_KB + 64 * 136 * 2, GP_DL = GP_QB + 64 * 136 * 2, GP_END = GP_DL + 4 * 16 * 16 * 4;
static_assert(GP_END <= RING_BYTES, "gdn prep LDS");
__device__ __forceinline__ void gdn_prep_phase(Frame& F, int layer) {
    bf16* const PROJ = WSP(bf16, WS_PROJ); bf16* const NEGW = WSP(bf16, WS_NEGW); bf16* const QDEC = WSP(bf16, WS_QDEC); bf16* const KDT = WSP(bf16, WS_KDT); bf16* const INTRA = WSP(bf16, WS_INTRA);
    float* const SMALL = WSP(float, WS_SMALL); float* const UT = WSP(float, WS_UT); float* const EGL = WSP(float, WS_EGL);
    const float* const gconv_w = INP(6); const float* const g_Alog = INP(7); const float* const g_dtb = INP(8);
    LAS bf16* KB = (LAS bf16*)(F.lds + GP_KB);
    LAS bf16* QB = (LAS bf16*)(F.lds + GP_QB);
    const int tid = F.tid, lane = F.lane, w = F.wave;
    const float* convw = gconv_w + (size_t)layer * 4 * (3 * GDN_DIM);
#ifndef PREP_REP
#define PREP_REP 1
#endif
    const int nun1 = (NUNIT_GDN - F.bx + F.G - 1) / F.G, nun = nun1 * PREP_REP;
    if (nun <= 0) return;
    if (w < 4) {
        const int cg = tid & 15, tq = tid >> 4, tb = 4 * tq;
        v4u rows[3][7];
#define GP_FETCH(u_) do { const int bh_ = (u_) >> 6, n_ = (u_) & 63, b_ = bh_ / NH, h_ = bh_ % NH, m0_ = b_ * SEQ + n_ * 64; const bool ok_ = (n_ * 64 + tb) > 0;     \
        const bf16* p0_ = PROJ + (size_t)(m0_ + tb) * PQ + (C_GQ + h_ * HD + cg * 8); \
        _Pragma("unroll") for (int wh = 0; wh < 3; ++wh) _Pragma("unroll") for (int i = 0; i < 7; ++i) { const v4u r_ = *(const v4u*)(p0_ + wh * GDN_DIM + (ptrdiff_t)((i < 3 && !ok_) ? 0 : i - 3) * PQ); rows[wh][i] = (i < 3 && !ok_) ? (v4u){0u, 0u, 0u, 0u} : r_; } } while (0)
        GP_FETCH(F.bx);
#pragma unroll 1
        for (int i = 0; i < nun; ++i) {
            const int u = F.bx + (i % nun1) * F.G, bh = u >> 6, h = bh % NH, sel = i & 1;
            LAS bf16* RT = (LAS bf16*)(F.lds + GP_RT + sel * GP_RT_SZ);
            LAS float* AL = (LAS float*)(F.lds + GP_AL + sel * GP_AL_SZ);
            const LAS float* GT = (const LAS float*)(F.lds + GP_GT + sel * GP_GT_SZ);
#ifndef PB_CONV
#define PB_CONV 1
#endif
#ifndef PB_B
#define PB_B 1
#endif
#ifndef PB_SOLVE
#define PB_SOLVE 1
#endif
            for (int pbc_ = 0; pbc_ < PB_CONV; ++pbc_)
#pragma unroll
            for (int wh = 0; wh < 3; ++wh) {
                const int wcol = wh * GDN_DIM + h * HD + cg * 8;
                float cw[4][8];
#pragma unroll
                for (int tap = 0; tap < 4; ++tap) { const f32x4 w0 = *(const f32x4*)(convw + (size_t)tap * (3 * GDN_DIM) + wcol), w1 = *(const f32x4*)(convw + (size_t)tap * (3 * GDN_DIM) + wcol + 4);
                    cw[tap][0] = w0.x; cw[tap][1] = w0.y; cw[tap][2] = w0.z; cw[tap][3] = w0.w; cw[tap][4] = w1.x; cw[tap][5] = w1.y; cw[tap][6] = w1.z; cw[tap][7] = w1.w; }
                LAS bf16* const qkrow = (wh == 0 ? QB : KB) + tb * 136 + cg * 8; LAS bf16* const rtrow = RT + tb * 264 + (wh == 1 ? 128 : 0) + cg * 8;
                float win[4][8]; unpack8(rows[wh][0], win[0]); unpack8(rows[wh][1], win[1]); unpack8(rows[wh][2], win[2]);
#pragma unroll
                for (int j = 0; j < 4; ++j) { float acc[8];
                    unpack8(rows[wh][j + 3], win[(j + 3) & 3]);
#pragma unroll
                    for (int e = 0; e < 8; ++e) acc[e] = cw[0][e] * win[j & 3][e] + cw[1][e] * win[(j + 1) & 3][e] + cw[2][e] * win[(j + 2) & 3][e] + cw[3][e] * win[(j + 3) & 3][e];
                    float ss = 0.f;
#pragma unroll
                    for (int e = 0; e < 8; ++e) { acc[e] = silu_f(acc[e]); ss += acc[e] * acc[e]; }
                    if (wh < 2) { ss += __shfl_xor(ss, 1); ss += __shfl_xor(ss, 2); ss += __shfl_xor(ss, 4); ss += __shfl_xor(ss, 8);
                        const float rn = rsqrtf(ss + EPS) * (wh == 0 ? 0.08838834764831845f : 1.f);
#pragma unroll
                        for (int e = 0; e < 8; ++e) acc[e] *= rn; }
                    const v4u pk = pack8(acc);
                    if (wh < 2) *(LAS v4u*)(qkrow + j * 136) = pk;
                    if (wh > 0) *(LAS v4u*)(rtrow + j * 264) = pk;
                }
            }
            __builtin_amdgcn_sched_barrier(0);
            if (i + 1 < nun) GP_FETCH(F.bx + ((i + 1) % nun1) * F.G);
            LDS_BAR();
            for (int pbb_ = 0; pbb_ < PB_B; ++pbb_) {
                const int ti = w, r16 = lane & 15, q4 = lane >> 4, c = 16 * ti + r16; const float gc = GT[c], bc = GT[64 + c];
#pragma unroll
                for (int mat = 0; mat < 2; ++mat) {
                    const LAS bf16* Xb = mat ? QB : KB; bf16x8 xf[4];
#pragma unroll
                    for (int ks = 0; ks < 4; ++ks) xf[ks] = *(const LAS bf16x8*)(Xb + c * 136 + 32 * ks + 8 * q4);
                    unsigned ipk[4][2];
#pragma unroll
                    for (int tj = 0; tj < 4; ++tj) {
                        f32x4 acc = (f32x4){0.f, 0.f, 0.f, 0.f};
                        if (tj <= ti) {
#pragma unroll
                            for (int ks = 0; ks < 4; ++ks) { const bf16x8 kf = *(const LAS bf16x8*)(KB + (16 * tj + r16) * 136 + 32 * ks + 8 * q4);
                                acc = __builtin_amdgcn_mfma_f32_16x16x32_bf16(kf, xf[ks], acc, 0, 0, 0); }
                        }
                        const int s0 = 16 * tj + 4 * q4; f32x4 o;
#pragma unroll
                        for (int r = 0; r < 4; ++r) { const int s = s0 + r; const float dec = __expf(fminf(gc - GT[s], 0.f));
                            o[r] = mat ? (c >= s ? acc[r] * dec : 0.f) : (c > s ? bc * acc[r] * dec : 0.f); }
                        if (mat) { ipk[tj][0] = pk2(o[0], o[1]); ipk[tj][1] = pk2(o[2], o[3]); }
                        else *(LAS f32x4*)(AL + c * 64 + s0) = o;
                    }
                    if (mat) { bf16* ir = INTRA + (size_t)u * 4096 + c * 64 + 8 * q4;
                        *(v4u*)ir = (v4u){ipk[0][0], ipk[0][1], ipk[1][0], ipk[1][1]}; *(v4u*)(ir + 32) = (v4u){ipk[2][0], ipk[2][1], ipk[3][0], ipk[3][1]}; }
                }
            }
#pragma unroll
            for (int it = 0; it < 4; ++it) {
                const int id = it * 256 + tid, t = id >> 4, pp = id & 15, kq = 32 * (pp >> 2) + 4 * (pp & 3);
                const u32x2 lo = *(const LAS u32x2*)(QB + t * 136 + kq), hi = *(const LAS u32x2*)(QB + t * 136 + kq + 16); float v[8]; unpack8((v4u){lo.x, lo.y, hi.x, hi.y}, v); const float eg = GT[128 + t];
#pragma unroll
                for (int e = 0; e < 8; ++e) v[e] *= eg;
                *(v4u*)(QDEC + (size_t)u * 8192 + t * 128 + 8 * pp) = pack8(v); }
            LDS_BAR();
        }
        LDS_BAR(); LDS_BAR();
#undef GP_FETCH
    } else {
        const int j = tid - 256;
        float ga = 0.f, gb = 0.f;
#define GP_GFETCH(u_) do { if (w == 4) { const int bh_ = (u_) >> 6, n_ = (u_) & 63, b_ = bh_ / NH, h_ = bh_ % NH, m0_ = b_ * SEQ + n_ * 64; ga = SMALL[(size_t)(m0_ + lane) * 64 + SM_GA + h_]; gb = SMALL[(size_t)(m0_ + lane) * 64 + SM_GB + h_]; } } while (0)
        GP_GFETCH(F.bx);
#pragma unroll 1
        for (int i = -1; i < nun; ++i) {
            const bool has_next = i + 1 < nun; const int un = F.bx + ((i + 1) % nun1) * F.G, seln = (i + 1) & 1;
            if (has_next && w == 4) {
                LAS float* GTn = (LAS float*)(F.lds + GP_GT + seln * GP_GT_SZ); const int hn = (un >> 6) % NH;
                const float beta = 1.f / (1.f + __expf(-gb));
                float g = -__expf(g_Alog[layer * NH + hn]) * softplus_f(ga + g_dtb[layer * NH + hn]);
#pragma unroll
                for (int off = 1; off < 64; off <<= 1) { const float v = __shfl_up(g, off); if (lane >= off) g += v; }
                const float eg = __expf(g);
                GTn[lane] = g; GTn[64 + lane] = beta; GTn[128 + lane] = eg; GTn[192 + lane] = beta * eg;
                if (i + 2 < nun) GP_GFETCH(F.bx + ((i + 2) % nun1) * F.G);
            }
            if (i >= 0) {
                const int u = F.bx + (i % nun1) * F.G, sel = i & 1;
                const LAS bf16* RT = (const LAS bf16*)(F.lds + GP_RT + sel * GP_RT_SZ); const LAS float* AL = (const LAS float*)(F.lds + GP_AL + sel * GP_AL_SZ); const LAS float* GT = (const LAS float*)(F.lds + GP_GT + sel * GP_GT_SZ);
                const int sw = w - 4, r16 = lane & 15, q4 = lane >> 4;
                LAS float* DL = (LAS float*)(F.lds + GP_DL);
                {
                    const LAS float* Ab = AL + (16 * q4) * 64 + 16 * q4; float d[16];
#pragma unroll
                    for (int r = 0; r < 16; ++r) { float a = (r == r16) ? 1.f : 0.f;
#pragma unroll
                        for (int k4 = 0; k4 < (r + 3) / 4; ++k4) { const f32x4 av = *(const LAS f32x4*)(Ab + r * 64 + 4 * k4);
#pragma unroll
                            for (int e = 0; e < 4; ++e) if (4 * k4 + e < r) a -= av[e] * d[4 * k4 + e]; }
                        d[r] = a; DL[(q4 * 16 + r) * 16 + r16] = a; }
                }
                asm volatile("s_waitcnt lgkmcnt(0)" ::: "memory");
                const LAS float* sc = GT + (sw < 2 ? 64 : 192);
                f32x4 X[4][4];
#pragma unroll
                for (int bi = 0; bi < 4; ++bi) {
                    f32x4 Y[4];
#pragma unroll
                    for (int ct = 0; ct < 4; ++ct)
#pragma unroll
                        for (int r = 0; r < 4; ++r) { const int row = 16 * bi + 4 * q4 + r; Y[ct][r] = bf2f(RT[row * 264 + 64 * sw + 16 * ct + r16]) * sc[row]; }
#pragma unroll
                    for (int bj = 0; bj < bi; ++bj) { const f32x4 av = *(const LAS f32x4*)(AL + (16 * bi + r16) * 64 + 16 * bj + 4 * q4);
#pragma unroll
                        for (int r = 0; r < 4; ++r)
#pragma unroll
                            for (int ct = 0; ct < 4; ++ct) Y[ct] = __builtin_amdgcn_mfma_f32_16x16x4f32(-av[r], X[bj][ct][r], Y[ct], 0, 0, 0); }
                    const f32x4 dv = *(const LAS f32x4*)(DL + (bi * 16 + r16) * 16 + 4 * q4);
#pragma unroll
                    for (int ct = 0; ct < 4; ++ct) X[bi][ct] = (f32x4){0.f, 0.f, 0.f, 0.f};
#pragma unroll
                    for (int r = 0; r < 4; ++r)
#pragma unroll
                        for (int ct = 0; ct < 4; ++ct) X[bi][ct] = __builtin_amdgcn_mfma_f32_16x16x4f32(dv[r], Y[ct][r], X[bi][ct], 0, 0, 0);
                }
                LDS_BAR();
                if (sw < 2) { float* dst = UT + (size_t)u * 8192 + (4 * q4) * 128 + 64 * sw + r16;
#pragma unroll
                    for (int bi = 0; bi < 4; ++bi)
#pragma unroll
                        for (int r = 0; r < 4; ++r)
#pragma unroll
                            for (int ct = 0; ct < 4; ++ct) dst[(16 * bi + r) * 128 + 16 * ct] = X[bi][ct][r];
                } else {
#pragma unroll
                    for (int ct = 0; ct < 4; ++ct) { bf16* dst = NEGW + (size_t)u * 8192 + (4 * q4) * 128 + kperm(64 * (sw - 2) + 16 * ct + r16);
#pragma unroll
                        for (int bi = 0; bi < 4; ++bi)
#pragma unroll
                            for (int r = 0; r < 4; ++r) dst[(16 * bi + r) * 128] = (bf16)f2bf(-X[bi][ct][r]); } }
            } else LDS_BAR();
            if (has_next) {
                const LAS float* GTn = (const LAS float*)(F.lds + GP_GT + seln * GP_GT_SZ); const float gl = GTn[63];
#pragma unroll
                for (int it = 0; it < 4; ++it) { const int id = it * 256 + j, dk = id & 127, pp = id >> 7, t0 = 32 * (pp >> 2) + 4 * (pp & 3); float v[8];
#pragma unroll
                    for (int e = 0; e < 8; ++e) { const int t = t0 + (e & 3) + 4 * (e & 4); v[e] = bf2f(KB[t * 136 + dk]) * __expf(gl - GTn[t]); }
                    *(v4u*)(KDT + (size_t)un * 8192 + dk * 64 + 8 * pp) = pack8(v); }
                if (j == 0) EGL[un] = GTn[128 + 63];
            }
            LDS_BAR();
        }
#undef GP_GFETCH
    }
}

constexpr int GS_NEGW = 0, GS_QDEC = 64 * 136 * 2, GS_INTRA = GS_QDEC + 64 * 136 * 2, GS_KDT = GS_INTRA + 64 * 72 * 2, GS_OB = GS_KDT + 128 * 72 * 2, GS_LU = GS_OB + 64 * 132 * 4, GS_END = GS_LU + 64 * 132 * 4;
static_assert(GS_END <= RING_BYTES, "gdn scan LDS");
__device__ __forceinline__ bf16x8 frag2(const LAS bf16* p) { const u32x2 lo = *(const LAS u32x2*)p, hi = *(const LAS u32x2*)(p + 16); v4u w; w.x = lo.x; w.y = lo.y; w.z = hi.x; w.w = hi.y; return __builtin_bit_cast(bf16x8, w); }
__device__ __forceinline__ bf16x8 packacc(const f32x4 a, const f32x4 b) { v4u w; w.x = pg8::cvt_pk_bf16(a[0], a[1]); w.y = pg8::cvt_pk_bf16(a[2], a[3]); w.z = pg8::cvt_pk_bf16(b[0], b[1]); w.w = pg8::cvt_pk_bf16(b[2], b[3]); return __builtin_bit_cast(bf16x8, w); }
__device__ __forceinline__ void gdn_scan_unit(Frame& F, int layer, const int bh) {
    bf16* const PROJ = WSP(bf16, WS_PROJ); bf16* const MIX = WSP(bf16, WS_MIX); bf16* const NEGW = WSP(bf16, WS_NEGW); bf16* const QDEC = WSP(bf16, WS_QDEC); bf16* const KDT = WSP(bf16, WS_KDT); bf16* const INTRA = WSP(bf16, WS_INTRA); float* const UT = WSP(float, WS_UT); float* const EGL = WSP(float, WS_EGL); const float* const g_ng = INP(9);
    LAS bf16* LN = (LAS bf16*)(F.lds + GS_NEGW); LAS bf16* LQ = (LAS bf16*)(F.lds + GS_QDEC); LAS bf16* LI = (LAS bf16*)(F.lds + GS_INTRA); LAS bf16* LK = (LAS bf16*)(F.lds + GS_KDT);
    LAS float* OB = (LAS float*)(F.lds + GS_OB);
    LAS float* LU = (LAS float*)(F.lds + GS_LU);
    const int tid = F.tid, lane = F.lane, w = F.wave, r16 = lane & 15, q4 = lane >> 4;
    const float* ngain = g_ng + layer * HD;
    {
        const int b = bh / NH, h = bh % NH;
        f32x4 Sacc[8]; bf16x8 Sb[4];
#pragma unroll
        for (int i = 0; i < 8; ++i) Sacc[i] = (f32x4){0.f, 0.f, 0.f, 0.f};
#pragma unroll
        for (int i = 0; i < 4; ++i) Sb[i] = (bf16x8){0, 0, 0, 0, 0, 0, 0, 0};
        v4u st[11]; float egl;
        const int tok = tid >> 3, part = tid & 7;
#define GS_LOAD(n_) do { const size_t u_ = (size_t)bh * 64 + (n_); \
            st[0] = *(const v4u*)(NEGW + u_ * 8192 + (size_t)tid * 8); st[1] = *(const v4u*)(NEGW + u_ * 8192 + (size_t)(tid + 512) * 8); \
            st[2] = *(const v4u*)(QDEC + u_ * 8192 + (size_t)tid * 8); st[3] = *(const v4u*)(QDEC + u_ * 8192 + (size_t)(tid + 512) * 8); \
            st[4] = *(const v4u*)(INTRA + u_ * 4096 + (size_t)tid * 8); \
            st[5] = *(const v4u*)(KDT + u_ * 8192 + (size_t)tid * 8); st[6] = *(const v4u*)(KDT + u_ * 8192 + (size_t)(tid + 512) * 8); \
            _Pragma("unroll") for (int k_ = 0; k_ < 4; ++k_) st[7 + k_] = *(const v4u*)(UT + u_ * 8192 + (size_t)(tid + 512 * k_) * 4); \
            egl = EGL[u_]; } while (0)
#define GS_STORE() do { \
            *(LAS v4u*)(LN + (tid >> 4) * 136 + (tid & 15) * 8) = st[0]; *(LAS v4u*)(LN + ((tid + 512) >> 4) * 136 + (tid & 15) * 8) = st[1]; \
            *(LAS v4u*)(LQ + (tid >> 4) * 136 + (tid & 15) * 8) = st[2]; *(LAS v4u*)(LQ + ((tid + 512) >> 4) * 136 + (tid & 15) * 8) = st[3]; \
            *(LAS v4u*)(LI + (tid >> 3) * 72 + (tid & 7) * 8) = st[4]; \
            *(LAS v4u*)(LK + (tid >> 3) * 72 + (tid & 7) * 8) = st[5]; *(LAS v4u*)(LK + ((tid + 512) >> 3) * 72 + (tid & 7) * 8) = st[6]; \
            _Pragma("unroll") for (int k_ = 0; k_ < 4; ++k_) *(LAS v4u*)(LU + ((tid + 512 * k_) >> 5) * 132 + ((tid + 512 * k_) & 31) * 4) = st[7 + k_]; } while (0)
        GS_LOAD(0); GS_STORE();
        float eglc; v4u zq[2], zn[2];
        eglc = egl;
        { const bf16* zp = PROJ + (size_t)(b * SEQ + tok) * PQ + C_GZ + h * HD + 16 * part; zq[0] = *(const v4u*)zp; zq[1] = *(const v4u*)(zp + 8); }
        LDS_BAR();
        const LAS float* fU = LU + (4 * q4) * 132 + 16 * w + r16;
        const LAS bf16* fN = LN + r16 * 136 + 8 * q4; const LAS bf16* fQ = LQ + r16 * 136 + 8 * q4; const LAS bf16* fI = LI + r16 * 72 + 8 * q4; const LAS bf16* fK = LK + r16 * 72 + 8 * q4;
#define GS_RD4(buf, e0, e1, e2, e3) do { buf[0] = *(const LAS bf16x8*)(e0); buf[1] = *(const LAS bf16x8*)(e1); buf[2] = *(const LAS bf16x8*)(e2); buf[3] = *(const LAS bf16x8*)(e3); } while (0)
#define GS_SB() __builtin_amdgcn_sched_barrier(0)
#define GS_MMA(acc, a, bop) acc = __builtin_amdgcn_mfma_f32_16x16x32_bf16(a, bop, acc, 0, 0, 0)
#pragma unroll 1
        for (int n = 0; n < NCHUNK; ++n) {
            if (n + 1 < NCHUNK) { GS_LOAD(n + 1); const bf16* zp = PROJ + (size_t)(b * SEQ + (n + 1) * 64 + tok) * PQ + C_GZ + h * HD + 16 * part; zn[0] = *(const v4u*)zp; zn[1] = *(const v4u*)(zp + 8); }
            bf16x8 fa[4], fb[4]; f32x4 vacc[4], oacc[4]; bf16x8 vb[2];
            GS_RD4(fa, fQ + 0 * 16 * 136, fQ + 0 * 16 * 136 + 32, fQ + 0 * 16 * 136 + 64, fQ + 0 * 16 * 136 + 96);
            GS_RD4(fb, fQ + 1 * 16 * 136, fQ + 1 * 16 * 136 + 32, fQ + 1 * 16 * 136 + 64, fQ + 1 * 16 * 136 + 96); GS_SB();
            oacc[0] = (f32x4){0.f, 0.f, 0.f, 0.f}; GS_MMA(oacc[0], fa[0], Sb[0]); GS_MMA(oacc[0], fa[1], Sb[1]); GS_MMA(oacc[0], fa[2], Sb[2]); GS_MMA(oacc[0], fa[3], Sb[3]);
            GS_RD4(fa, fQ + 2 * 16 * 136, fQ + 2 * 16 * 136 + 32, fQ + 2 * 16 * 136 + 64, fQ + 2 * 16 * 136 + 96); GS_SB();
            oacc[1] = (f32x4){0.f, 0.f, 0.f, 0.f}; GS_MMA(oacc[1], fb[0], Sb[0]); GS_MMA(oacc[1], fb[1], Sb[1]); GS_MMA(oacc[1], fb[2], Sb[2]); GS_MMA(oacc[1], fb[3], Sb[3]);
            GS_RD4(fb, fQ + 3 * 16 * 136, fQ + 3 * 16 * 136 + 32, fQ + 3 * 16 * 136 + 64, fQ + 3 * 16 * 136 + 96); GS_SB();
            oacc[2] = (f32x4){0.f, 0.f, 0.f, 0.f}; GS_MMA(oacc[2], fa[0], Sb[0]); GS_MMA(oacc[2], fa[1], Sb[1]); GS_MMA(oacc[2], fa[2], Sb[2]); GS_MMA(oacc[2], fa[3], Sb[3]);
            GS_RD4(fa, fN + 0 * 16 * 136, fN + 0 * 16 * 136 + 32, fN + 0 * 16 * 136 + 64, fN + 0 * 16 * 136 + 96); GS_SB();
            oacc[3] = (f32x4){0.f, 0.f, 0.f, 0.f}; GS_MMA(oacc[3], fb[0], Sb[0]); GS_MMA(oacc[3], fb[1], Sb[1]); GS_MMA(oacc[3], fb[2], Sb[2]); GS_MMA(oacc[3], fb[3], Sb[3]);
            GS_RD4(fb, fN + 1 * 16 * 136, fN + 1 * 16 * 136 + 32, fN + 1 * 16 * 136 + 64, fN + 1 * 16 * 136 + 96); GS_SB();
            vacc[0] = (f32x4){fU[(0 * 16 + 0) * 132], fU[(0 * 16 + 1) * 132], fU[(0 * 16 + 2) * 132], fU[(0 * 16 + 3) * 132]}; GS_MMA(vacc[0], fa[0], Sb[0]); GS_MMA(vacc[0], fa[1], Sb[1]); GS_MMA(vacc[0], fa[2], Sb[2]); GS_MMA(vacc[0], fa[3], Sb[3]);
            GS_RD4(fa, fN + 2 * 16 * 136, fN + 2 * 16 * 136 + 32, fN + 2 * 16 * 136 + 64, fN + 2 * 16 * 136 + 96); GS_SB();
            vacc[1] = (f32x4){fU[(1 * 16 + 0) * 132], fU[(1 * 16 + 1) * 132], fU[(1 * 16 + 2) * 132], fU[(1 * 16 + 3) * 132]}; GS_MMA(vacc[1], fb[0], Sb[0]); GS_MMA(vacc[1], fb[1], Sb[1]); GS_MMA(vacc[1], fb[2], Sb[2]); GS_MMA(vacc[1], fb[3], Sb[3]);
            GS_RD4(fb, fN + 3 * 16 * 136, fN + 3 * 16 * 136 + 32, fN + 3 * 16 * 136 + 64, fN + 3 * 16 * 136 + 96); GS_SB();
            vacc[2] = (f32x4){fU[(2 * 16 + 0) * 132], fU[(2 * 16 + 1) * 132], fU[(2 * 16 + 2) * 132], fU[(2 * 16 + 3) * 132]}; GS_MMA(vacc[2], fa[0], Sb[0]); GS_MMA(vacc[2], fa[1], Sb[1]); GS_MMA(vacc[2], fa[2], Sb[2]); GS_MMA(vacc[2], fa[3], Sb[3]);
            GS_RD4(fa, fI + 0 * 16 * 72, fI + 0 * 16 * 72 + 32, fI + 1 * 16 * 72, fI + 1 * 16 * 72 + 32); GS_SB();
            vacc[3] = (f32x4){fU[(3 * 16 + 0) * 132], fU[(3 * 16 + 1) * 132], fU[(3 * 16 + 2) * 132], fU[(3 * 16 + 3) * 132]}; GS_MMA(vacc[3], fb[0], Sb[0]); GS_MMA(vacc[3], fb[1], Sb[1]); GS_MMA(vacc[3], fb[2], Sb[2]); GS_MMA(vacc[3], fb[3], Sb[3]);
            GS_RD4(fb, fI + 2 * 16 * 72, fI + 2 * 16 * 72 + 32, fI + 3 * 16 * 72, fI + 3 * 16 * 72 + 32); GS_SB();
            vb[0] = packacc(vacc[0], vacc[1]); vb[1] = packacc(vacc[2], vacc[3]);
            GS_MMA(oacc[0], fa[0], vb[0]); GS_MMA(oacc[0], fa[1], vb[1]); GS_MMA(oacc[1], fa[2], vb[0]); GS_MMA(oacc[1], fa[3], vb[1]);
            GS_RD4(fa, fK + 0 * 16 * 72, fK + 0 * 16 * 72 + 32, fK + 1 * 16 * 72, fK + 1 * 16 * 72 + 32); GS_SB();
            GS_MMA(oacc[2], fb[0], vb[0]); GS_MMA(oacc[2], fb[1], vb[1]); GS_MMA(oacc[3], fb[2], vb[0]); GS_MMA(oacc[3], fb[3], vb[1]);
            GS_RD4(fb, fK + 2 * 16 * 72, fK + 2 * 16 * 72 + 32, fK + 3 * 16 * 72, fK + 3 * 16 * 72 + 32); GS_SB();
#pragma unroll
            for (int m8 = 0; m8 < 8; ++m8) Sacc[m8] = Sacc[m8] * eglc;
            GS_MMA(Sacc[0], fa[0], vb[0]); GS_MMA(Sacc[0], fa[1], vb[1]); GS_MMA(Sacc[1], fa[2], vb[0]); GS_MMA(Sacc[1], fa[3], vb[1]);
            GS_RD4(fa, fK + 4 * 16 * 72, fK + 4 * 16 * 72 + 32, fK + 5 * 16 * 72, fK + 5 * 16 * 72 + 32); GS_SB();
            GS_MMA(Sacc[2], fb[0], vb[0]); GS_MMA(Sacc[2], fb[1], vb[1]); GS_MMA(Sacc[3], fb[2], vb[0]); GS_MMA(Sacc[3], fb[3], vb[1]);
            GS_RD4(fb, fK + 6 * 16 * 72, fK + 6 * 16 * 72 + 32, fK + 7 * 16 * 72, fK + 7 * 16 * 72 + 32); GS_SB();
            GS_MMA(Sacc[4], fa[0], vb[0]); GS_MMA(Sacc[4], fa[1], vb[1]); GS_MMA(Sacc[5], fa[2], vb[0]); GS_MMA(Sacc[5], fa[3], vb[1]); GS_SB();
            GS_MMA(Sacc[6], fb[0], vb[0]); GS_MMA(Sacc[6], fb[1], vb[1]); GS_MMA(Sacc[7], fb[2], vb[0]); GS_MMA(Sacc[7], fb[3], vb[1]);
#pragma unroll
            for (int s = 0; s < 4; ++s) Sb[s] = packacc(Sacc[2 * s], Sacc[2 * s + 1]);
#pragma unroll
            for (int mt = 0; mt < 4; ++mt)
#pragma unroll
                for (int r = 0; r < 4; ++r) OB[(16 * mt + 4 * q4 + r) * 132 + 16 * w + r16] = oacc[mt][r];
            LDS_BAR();
            {
                float o[16]; float ss = 0.f;
#pragma unroll
                for (int i = 0; i < 4; ++i) { const f32x4 v = *(const LAS f32x4*)(OB + tok * 132 + 16 * part + 4 * i); o[4 * i] = v.x; o[4 * i + 1] = v.y; o[4 * i + 2] = v.z; o[4 * i + 3] = v.w; ss += (v.x * v.x + v.y * v.y) + (v.z * v.z + v.w * v.w); }
                ss += __shfl_xor(ss, 1); ss += __shfl_xor(ss, 2); ss += __shfl_xor(ss, 4);
                const float rn = rsqrtf(ss * (1.f / HD) + EPS);
                float z[16]; { float t8[8]; unpack8(zq[0], t8);
#pragma unroll
                    for (int e = 0; e < 8; ++e) z[e] = t8[e];
                    unpack8(zq[1], t8);
#pragma unroll
                    for (int e = 0; e < 8; ++e) z[8 + e] = t8[e]; }
                float r8[8];
                bf16* dst = MIX + (size_t)(b * SEQ + n * 64 + tok) * DM + POOL_DIM + ATTN_DIM + h * HD + 16 * part;
#pragma unroll
                for (int hf = 0; hf < 2; ++hf) {
#pragma unroll
                    for (int e = 0; e < 8; ++e) { const int d = 8 * hf + e; r8[e] = o[d] * rn * ngain[16 * part + d] * silu_f(z[d]); }
                    *(v4u*)(dst + 8 * hf) = pack8(r8); }
            }
            if (n + 1 < NCHUNK) { GS_STORE(); eglc = egl; zq[0] = zn[0]; zq[1] = zn[1]; }
            LDS_BAR();
        }
#undef GS_RD4
#undef GS_SB
#undef GS_MMA
#undef GS_LOAD
#undef GS_STORE
    }
}

__device__ __forceinline__ unsigned wg_grab(Frame& F, unsigned* qc, LAS unsigned* slot) {
    if (F.tid == 0) *slot = __hip_atomic_fetch_add(qc, 1u, __ATOMIC_RELAXED, __HIP_MEMORY_SCOPE_AGENT);
    __syncthreads(); const unsigned v = *slot; __syncthreads();
    return (unsigned)__builtin_amdgcn_readfirstlane((int)v);
}
__device__ __forceinline__ void mix2_phase(Frame& F, int layer, int rep = 0) {
    constexpr unsigned NSCAN = BATCH * NH, NBLK = BATCH * NH * (SEQ / fox::QB), END = NSCAN + NBLK, NPOOL = (M / 64) * 4, ENDP = END + NPOOL;
    unsigned* qc = (unsigned*)(F.ws + WS_CTL) + CW_Q + 64 * (layer + DEPTH * rep);
    LAS unsigned* slot = (LAS unsigned*)(F.lds + MISC_OFF + 64);
    LAS int* LJ = (LAS int*)(F.lds + RING_BYTES - 3072);
    { const int* JLO = WSP(int, WS_JLO); for (int i = F.tid; i < BATCH * NH * (SEQ / fox::QB); i += NTHR) LJ[i] = JLO[i]; }
    unsigned idx = wg_grab(F, qc, slot);
#ifndef SCAN_REP
#define SCAN_REP 1
#endif
    while (idx < NSCAN) { for (int r_ = 0; r_ < SCAN_REP; ++r_) { PHASE_LOCAL(); gdn_scan_unit(F, layer, (int)idx); } idx = wg_grab(F, qc, slot); }
    if (idx < END) {
        PHASE_LOCAL();
        fox::Ctx c; c.PROJ = WSP(bf16, WS_PROJ); c.MIX = WSP(bf16, WS_MIX); c.NCK = WSP(float, WS_NCK); c.qc = qc; c.first = NSCAN; c.end = END; c.slot = slot; c.jl = LJ;
        fox::BlockRef cur = fox::item_ref(c, idx);
        fox::Seam S;
        fox::fox_prime<DM>(cur, (fox::lchar*)F.lds, S);
        for (;;) {
            unsigned ni; fox::fox_block<DM>(cur, c, (fox::lchar*)F.lds, S, ni);
            idx = ni;
            if (ni >= END) break;
            cur = fox::item_ref(c, ni);
        }
    }
    while (idx < ENDP) { PHASE_LOCAL(); pool_unit(F, layer, (int)(idx - END)); idx = wg_grab(F, qc, slot); }
}

__device__ __forceinline__ void convfix_phase(Frame& F, int layer) {
    bf16* const ACT = WSP(bf16, WS_ACT); const float* const HB = WSP(float, WS_HB); const float* const fconv_w = INP(13);
    constexpr int NPN = FFN2 / 256, NIT = (M / 256) * NPN * 2 * 16;
    const float* cw = fconv_w + (size_t)layer * 3 * FFN2;
    for (int it = F.bx * NTHR + F.tid; it < NIT; it += F.G * NTHR) {
        const int cg = it & 15, row = (it >> 4) & 1, t2 = it >> 5, pn = t2 % NPN, pm = t2 / NPN, ch = 128 * pn + 8 * cg;
        const float* cur = HB + (size_t)(pm * NPN + pn) * 1024; const float* prv = cur - (size_t)NPN * 1024; const bool has_prev = (pm & 15) != 0;
        float x0[2][8], x1[2][8], x2[2][8];
#pragma unroll
        for (int hf = 0; hf < 2; ++hf) { const int c = hf * 128 + 8 * cg;
            const f32x4 z = (f32x4){0.f, 0.f, 0.f, 0.f};
            const f32x4 a0 = *(const f32x4*)(cur + row * 256 + c), a1 = *(const f32x4*)(cur + row * 256 + c + 4);
            f32x4 b0, b1, c0, c1;
            if (row == 0) { b0 = has_prev ? *(const f32x4*)(prv + 3 * 256 + c) : z; b1 = has_prev ? *(const f32x4*)(prv + 3 * 256 + c + 4) : z; c0 = has_prev ? *(const f32x4*)(prv + 2 * 256 + c) : z; c1 = has_prev ? *(const f32x4*)(prv + 2 * 256 + c + 4) : z; }
            else { b0 = *(const f32x4*)(cur + c); b1 = *(const f32x4*)(cur + c + 4); c0 = has_prev ? *(const f32x4*)(prv + 3 * 256 + c) : z; c1 = has_prev ? *(const f32x4*)(prv + 3 * 256 + c + 4) : z; }
#pragma unroll
            for (int i = 0; i < 4; ++i) { x0[hf][i] = a0[i]; x0[hf][4 + i] = a1[i]; x1[hf][i] = b0[i]; x1[hf][4 + i] = b1[i]; x2[hf][i] = c0[i]; x2[hf][4 + i] = c1[i]; } }
        float o[8];
#pragma unroll
        for (int e = 0; e < 8; ++e) {
            const float gc = cw[ch + e] * x2[0][e] + cw[FFN2 + ch + e] * x1[0][e] + cw[2 * FFN2 + ch + e] * x0[0][e];
            const float uc = cw[FFN + ch + e] * x2[1][e] + cw[FFN2 + FFN + ch + e] * x1[1][e] + cw[2 * FFN2 + FFN + ch + e] * x0[1][e];
            o[e] = silu_f(gc) * uc; }
        *(v4u*)(ACT + (size_t)(pm * 256 + row) * FFN + ch) = pack8(o);
    }
}
#ifndef MK_PER_PHASE
#define MK_PER_PHASE 0
#endif
constexpr int WGM_IN = 4, WGM_O = 4, WGM_UP = 8, WGM_DN = 4;
constexpr int BG_QUOTA = 3;
__device__ __forceinline__ bool short_wg(int nwg, int G, int c) { const int rounds = (nwg + G - 1) / G; return (long)(rounds - 1) * G + c >= nwg; }
constexpr int PPL = 7, N_PHASES = 2 + PPL * DEPTH;
struct Args { const float* in[16]; float* out; unsigned char* ws; int ph_lo, ph_hi, fuse_fn, pad_; };
static_assert(sizeof(Args) == 16 * 8 + 8 + 8 + 16, "Args has no padding");
constexpr int WGM_FN = 2;
__global__ void __launch_bounds__(NTHR, 2) hybrid_fwd(Args args) {
    extern __shared__ __attribute__((aligned(16))) unsigned char lds_raw[];
    Frame F;
    F.lds = (lptr)lds_raw;
    F.tid = threadIdx.x; F.lane = F.tid & 63; F.wave = __builtin_amdgcn_readfirstlane(F.tid >> 6); F.G = gridDim.x; F.bx = blockIdx.x; F.z = 0;
    F.ws = args.ws; F.ka = (const float* const __attribute__((address_space(4)))*)__builtin_amdgcn_kernarg_segment_ptr();
    for (int u = F.tid; u < (LDS_BYTES - LDSCTL_OFF) / 4; u += NTHR) ((LAS unsigned*)(F.lds + LDSCTL_OFF))[u] = 0u;
    __syncthreads();
    const int lo = args.ph_lo, hi = args.ph_hi; const bool fuse_fn = args.fuse_fn != 0;
    XcdBarrier bar; bar.bar = (unsigned*)(F.ws + WS_CTL) + CW_BAR; bar.x = 0; bar.st = nullptr;
    if (hi - lo > 1) bar = xcd_barrier_post((unsigned*)(F.ws + WS_CTL) + CW_BAR, (volatile LAS unsigned*)(F.lds + MISC_OFF) + 8);
#ifndef PHM
#define PHM 0xFFFF
#endif
#define IN(k) (lo <= (k) && (k) < hi)
#define EN(b) ((PHM >> (b)) & 1)
#define SEAM(k) do { if (IN(k) && IN((k) + 1)) xcd_barrier(bar); } while (0)
#ifndef DBL
#define DBL 0
#endif
#define REP(k) for (int rep_ = 0; rep_ < (((DBL >> (k)) & 1) ? 2 : 1); ++rep_)

    float* const RS = (float*)(F.ws + WS_CTL) + CW_RS;
    constexpr float INVK = 1.f / DM;
    if (IN(0)) { PHASE_LOCAL(); p0_prologue(F); PHASE_LOCAL(); cast_rows_stat(F, INP(0), WSP(bf16, WS_XN), RS); SEAM(0); }
#pragma unroll 1
    for (int l = 0; l < DEPTH; ++l) {
        const int pb = 1 + PPL * l;
        if (IN(pb + 0)) {
            PHASE_LOCAL(); pg8::Gemm g{WSP(bf16, WS_XN), WSP(bf16, WS_WIN) + (size_t)l * NPROJ * DM, M, NPROJ, DM}; pg8::StaticOrder S; S.init(M, NPROJ, F.G, F.bx, WGM_IN);
            pg8::EpiProj E{(const LAS float*)(F.lds + pg8::RSL_OFF), WSP(bf16, WS_PROJ), PQ, WSP(float, WS_SMALL), PN_SMALL, RS + (size_t)(2 * l) * M, INVK, EPS, (float*)(F.ws + WS_CTL) + CW_BND + l * (BATCH * 24 * 4)};
            pg8::gemm_phase<pg8::EpiProj, pg8::StaticOrder, true, true>(F.lds, g, S, E);
            if (short_wg(S.nwg, F.G, F.bx)) { PHASE_LOCAL(); bg_convert(F, BG_QUOTA, CV_NPER); }
            SEAM(pb + 0);
        }
        if (IN(pb + 1)) { PHASE_LOCAL(); gdn_prep_phase(F, l); PHASE_LOCAL(); fox_cum_phase(F, l); SEAM(pb + 1); }
        if (IN(pb + 2)) { PHASE_LOCAL(); mix2_phase(F, l); if (l == 1) { PHASE_LOCAL(); bg_convert(F, 1 << 30, CV_W_O); } SEAM(pb + 2); }
        if (IN(pb + 3)) {
            PHASE_LOCAL(); pg8::Gemm g{WSP(bf16, WS_MIX), WSP(bf16, WS_WO) + (size_t)l * DM * DM, M, DM, DM}; pg8::StaticOrder S; S.init(M, DM, F.G, F.bx, WGM_O);
            pg8::EpiResidBfStat E{WSP(bf16, WS_XN), DM, RS + (size_t)(2 * l + 1) * M};
            pg8::gemm_phase<pg8::EpiResidBfStat, pg8::StaticOrder, true, true>(F.lds, g, S, E);
            if (l == 1) { PHASE_LOCAL(); bg_convert(F, 1 << 30, CV_W_UP); }
            SEAM(pb + 3);
        }
        if (IN(pb + 4)) {
            PHASE_LOCAL(); pg8::Gemm g{WSP(bf16, WS_XN), WSP(bf16, WS_WUP) + (size_t)l * FFN2 * DM, M, FFN2, DM}; pg8::StaticOrder S; S.init(M, FFN2, F.G, F.bx, WGM_UP);
            pg8::EpiConvGate E{(const LAS float*)(F.lds + pg8::RSL_OFF), WSP(bf16, WS_ACT), FFN, INP(13) + (size_t)l * 3 * FFN2, FFN, WSP(float, WS_HB), FFN2 / 256, (LAS float*)(F.lds + pg8::STAGE_BYTES), RS + (size_t)(2 * l + 1) * M, INVK, EPS};
            pg8::gemm_phase<pg8::EpiConvGate, pg8::StaticOrder, true, true>(F.lds, g, S, E);
            if (short_wg(S.nwg, F.G, F.bx)) { PHASE_LOCAL(); bg_convert(F, BG_QUOTA, CV_NPER); }
            SEAM(pb + 4);
        }
        if (IN(pb + 5)) { PHASE_LOCAL(); convfix_phase(F, l); if (l == 1) { PHASE_LOCAL(); bg_convert(F, 1 << 30, CV_NPER); } SEAM(pb + 5); }
        if (IN(pb + 6)) {
            PHASE_LOCAL(); pg8::Gemm g{WSP(bf16, WS_ACT), WSP(bf16, WS_WDN) + (size_t)l * DM * FFN, M, DM, FFN}; pg8::StaticOrder S; S.init(M, DM, F.G, F.bx, WGM_DN);
            if (l + 1 < DEPTH) { pg8::EpiResidBfStat E{WSP(bf16, WS_XN), DM, RS + (size_t)(2 * l + 2) * M};
                pg8::gemm_phase<pg8::EpiResidBfStat, pg8::StaticOrder, true, true>(F.lds, g, S, E);
                PHASE_LOCAL(); bg_convert(F, 1 << 30, CV_W_IN); }
            else if (fuse_fn) { S.init(M, DM, F.G, F.bx, WGM_FN);
                pg8::EpiFinalNorm E{WSP(bf16, WS_XN), (float*)F.ka[16 + F.z], DM, RS + (size_t)(2 * DEPTH) * M, (unsigned*)(F.ws + WS_CTL) + CW_FN, INP(15), INVK, EPS, (unsigned)(DM / 256)};
                pg8::gemm_phase<pg8::EpiFinalNorm, pg8::StaticOrder, true, true>(F.lds, g, S, E); }
            else { pg8::EpiResidBfOut E{WSP(bf16, WS_XN), WSP(float, WS_X), DM};
                pg8::gemm_phase<pg8::EpiResidBfOut, pg8::StaticOrder, true, true>(F.lds, g, S, E); }
            if (!(fuse_fn && l + 1 == DEPTH)) SEAM(pb + 6);
        }
    }
    if (IN(N_PHASES - 1) && !fuse_fn) { PHASE_LOCAL(); rms_rows_f32(F, WSP(float, WS_X), INP(15), (float*)F.ka[16 + F.z]); }
#undef IN
#undef SEAM
}

extern "C" void kernel_launch(void* const* d_in, const int* in_sizes, int n_in, void* d_out, int out_size, void* d_ws, size_t ws_size, hipStream_t stream) {
    static int grid = 0; static bool fuse_ok = false;
    if (grid == 0) {
        if (n_in != 16 || in_sizes[0] != M * DM || out_size != M * DM || ws_size < WS_END) { fprintf(stderr, "kernel_launch: shape/workspace mismatch (n_in %d, in0 %d, out %d, ws %zu, need %zu); nothing launched\n", n_in, n_in > 0 ? in_sizes[0] : -1, out_size, ws_size, (size_t)WS_END); grid = -1; return; }
        int dev = 0, cus = 0, per_cu = 0;
        if (hipGetDevice(&dev) != hipSuccess || hipDeviceGetAttribute(&cus, hipDeviceAttributeMultiprocessorCount, dev) != hipSuccess) { fprintf(stderr, "kernel_launch: device query failed\n"); grid = -1; return; }
        if (hipFuncSetAttribute((const void*)hybrid_fwd, hipFuncAttributeMaxDynamicSharedMemorySize, LDS_BYTES) != hipSuccess) { fprintf(stderr, "kernel_launch: hipFuncSetAttribute failed\n"); grid = -1; return; }
        if (hipOccupancyMaxActiveBlocksPerMultiprocessor(&per_cu, (const void*)hybrid_fwd, NTHR, LDS_BYTES) != hipSuccess || per_cu < 1) fprintf(stderr, "kernel_launch: note: occupancy query reports %d workgroups per CU\n", per_cu);
        (void)hipGetLastError();
        grid = cus;
        {
            static int round_of[(M / 256) * (DM / 256)]; bool ok = true; int seen = 0;
            for (int c = 0; c < grid; ++c) { pg8::StaticOrder S; S.init(M, DM, grid, c, WGM_FN); pg8::Unit u; for (int i = 0; S.next(i, u); ++i) { round_of[u.pm * (DM / 256) + u.pn] = i; ++seen; } }
            for (int pm = 0; pm < M / 256 && ok; ++pm) for (int pn = 1; pn < DM / 256; ++pn) if (round_of[pm * (DM / 256) + pn] != round_of[pm * (DM / 256)]) { ok = false; break; }
            fuse_ok = ok && seen == (M / 256) * (DM / 256);
        }
    }
    if (grid < 0) return;
    if (hipMemsetAsync((char*)d_ws + WS_CTL, 0, CTL_ZERO_BYTES, stream) != hipSuccess) { fprintf(stderr, "kernel_launch: memset failed\n"); return; }
    Args a{};
    for (int i = 0; i < 16; ++i) a.in[i] = (const float*)d_in[i];
    a.out = (float*)d_out; a.ws = (unsigned char*)d_ws; a.fuse_fn = (fuse_ok && !MK_PER_PHASE) ? 1 : 0;
#if MK_PER_PHASE
    for (int p = 0; p < N_PHASES; ++p) { a.ph_lo = p; a.ph_hi = p + 1; hipLaunchKernelGGL(hybrid_fwd, dim3(grid), dim3(NTHR), LDS_BYTES, stream, a); }
#else
    a.ph_lo = 0; a.ph_hi = N_PHASES; hipLaunchKernelGGL(hybrid_fwd, dim3(grid), dim3(NTHR), LDS_BYTES, stream, a);
#endif
    const hipError_t le = hipPeekAtLastError();
    if (le != hipSuccess) fprintf(stderr, "kernel_launch: launch failed: %s\n", hipGetErrorName(le));
}
```

```cpp
#include <hip/hip_runtime.h>
#include <cstdio>
#include <cstdint>
#include <cstddef>
__device__ __forceinline__ int tid_local() { int t; asm volatile("v_mov_b32 %0, %1" : "=v"(t) : "v"(threadIdx.x)); return t; }
namespace pg8 {
#define PG8_LAS __attribute__((address_space(3)))
typedef unsigned short bf16_t;
typedef short bf16x8 __attribute__((ext_vector_type(8)));
typedef float f32x4 __attribute__((ext_vector_type(4)));
typedef unsigned u32x4 __attribute__((ext_vector_type(4)));
constexpr int BM = 256, BK = 64, HALF = 128, HTB = HALF * BK * 2  , STAGE_BYTES = 8 * HTB, NXCD = 8, WGM = 4;

__host__ __device__ __forceinline__ int lds_byte(int r, int c) { const int st = (r >> 4) * 2 + (c >> 5), rr = r & 15, cc = c & 31, ob = rr * 64 + cc * 2; return st * 1024 + (ob ^ (((ob >> 9) & 1) << 5)); }
__host__ __device__ __forceinline__ void stage_rc(int b, int& R, int& C) { const int st = b / 1024, sb = b % 1024, swz = sb ^ (((sb >> 9) & 1) << 5); R = (st >> 1) * 16 + swz / 64; C = (st & 1) * 32 + (swz % 64) / 2; }
__host__ __device__ __forceinline__ int perm32(int rho) { const int n = rho >> 4, i = rho & 15; return 8 * (i >> 2) + 4 * n + (i & 3); }

struct Unit { int pm, pn; };
struct Gemm { const bf16_t* A; const bf16_t* Bt; int M, N, K; };

struct StaticOrder {
    int nM, nN, nwg, G, c, wgm;
    __host__ __device__ void init(int M, int N, int G_, int c_, int wgm_ = WGM) { nM = M / BM; nN = N / BM; nwg = nM * nN; G = G_; c = c_; wgm = wgm_; }
    __host__ __device__ bool next(int i, Unit& u) const {
        const long L = (long)i * G + c; if (L >= nwg) return false;
        int wgid = (int)L; { const int q = nwg / NXCD, r = nwg % NXCD, xcd = wgid % NXCD, off = wgid / NXCD; wgid = (xcd < r ? xcd * (q + 1) : r * (q + 1) + (xcd - r) * q) + off; }
        const int nig = wgm * nN, gid = wgid / nig, fm = gid * wgm, gsz = (nM - fm) < wgm ? (nM - fm) : wgm;
        u.pm = fm + ((wgid % nig) % gsz); u.pn = (wgid % nig) / gsz; return true;
    }
    __device__ __forceinline__ void a_ready(const Unit&) const {}
    __device__ __forceinline__ void done(const Unit&) const {}
};

typedef float f32x2_t __attribute__((ext_vector_type(2))); typedef __bf16 bf16x2_t __attribute__((ext_vector_type(2)));
__device__ __forceinline__ unsigned cvt_pk_bf16(float lo, float hi) { f32x2_t v = {lo, hi}; bf16x2_t b = __builtin_convertvector(v, bf16x2_t); return __builtin_bit_cast(unsigned, b); }
typedef float f32x2 __attribute__((ext_vector_type(2)));
__device__ __forceinline__ void rstd_rows(const float* rss, int row0, float inv_k, float eps, float (&rs)[2][4]) {
#pragma unroll
    for (int ai = 0; ai < 2; ++ai)
#pragma unroll
        for (int m = 0; m < 4; ++m) rs[ai][m] = __builtin_amdgcn_rsqf(rss[row0 + ai * HALF + m * 16] * inv_k + eps);
}
struct EpiProj {
    static constexpr bool PERM = true, AFTER_DRAIN = false;
    bf16_t* O; int ldc; float* small; int pn_small; const float* rss; float inv_k, eps; float* bnd;
    __device__ __forceinline__ void operator()(const f32x4 (&acc)[2][2][4][2], const Unit& u, int wr, int wc, int fr, int fq) const {
        const int row0 = u.pm * BM + wr * 64 + fr, col0 = u.pn * BM + wc * 32 + 8 * fq;
        float rs[2][4]; rstd_rows(rss, row0, inv_k, eps, rs);
        if (u.pn >= 4 && u.pn < 16) {
            float mx[2] = {0.f, 0.f};
#pragma unroll
            for (int ai = 0; ai < 2; ++ai)
#pragma unroll
                for (int m = 0; m < 4; ++m)
#pragma unroll
                    for (int bj = 0; bj < 2; ++bj) { const f32x4 v0 = acc[ai][bj][m][0] * rs[ai][m], v1 = acc[ai][bj][m][1] * rs[ai][m];
                        float ss = (v0[0] * v0[0] + v0[1] * v0[1]) + (v0[2] * v0[2] + v0[3] * v0[3]) + (v1[0] * v1[0] + v1[1] * v1[1]) + (v1[2] * v1[2] + v1[3] * v1[3]);
                        ss += __shfl_xor(ss, 16); ss += __shfl_xor(ss, 32);
                        mx[bj] = fmaxf(mx[bj], ss); }
#pragma unroll
            for (int bj = 0; bj < 2; ++bj) {
#pragma unroll
                for (int off = 1; off < 16; off <<= 1) mx[bj] = fmaxf(mx[bj], __shfl_xor(mx[bj], off));
                if (fr == 0 && fq == 0) (void)__hip_atomic_fetch_max((unsigned*)bnd + ((u.pm >> 4) * 24 + 2 * (u.pn - 4) + bj) * 4 + wc, __builtin_bit_cast(unsigned, mx[bj]), __ATOMIC_RELAXED, __HIP_MEMORY_SCOPE_AGENT); }
        }

        if (u.pn == pn_small) {
            if (wc < 2) {
#pragma unroll
                for (int ai = 0; ai < 2; ++ai)
#pragma unroll
                    for (int m = 0; m < 4; ++m) { float* sp = small + (size_t)(row0 + ai * HALF + m * 16) * 64 + wc * 32 + 8 * fq;
                        *(f32x4*)sp = acc[ai][0][m][0] * rs[ai][m]; *(f32x4*)(sp + 4) = acc[ai][0][m][1] * rs[ai][m]; }
            }
            return;
        }
#pragma unroll
        for (int ai = 0; ai < 2; ++ai)
#pragma unroll
            for (int m = 0; m < 4; ++m) { bf16_t* rowp = O + (size_t)(row0 + ai * HALF + m * 16) * ldc + col0;
#pragma unroll
                for (int bj = 0; bj < 2; ++bj) { const f32x4 v0 = acc[ai][bj][m][0] * rs[ai][m], v1 = acc[ai][bj][m][1] * rs[ai][m];
                    u32x4 w; w.x = cvt_pk_bf16(v0[0], v0[1]); w.y = cvt_pk_bf16(v0[2], v0[3]); w.z = cvt_pk_bf16(v1[0], v1[1]); w.w = cvt_pk_bf16(v1[2], v1[3]);
                    *(u32x4*)(rowp + bj * HALF) = w; } }
    }
};
struct EpiBf {
    static constexpr bool PERM = true, AFTER_DRAIN = false;
    bf16_t* O; int ldc;
    __device__ __forceinline__ void operator()(const f32x4 (&acc)[2][2][4][2], const Unit& u, int wr, int wc, int fr, int fq) const {
        const int row0 = u.pm * BM + wr * 64 + fr, col0 = u.pn * BM + wc * 32 + 8 * fq;
#pragma unroll
        for (int ai = 0; ai < 2; ++ai)
#pragma unroll
            for (int m = 0; m < 4; ++m) { bf16_t* rowp = O + (size_t)(row0 + ai * HALF + m * 16) * ldc + col0;
#pragma unroll
                for (int bj = 0; bj < 2; ++bj) { const f32x4 v0 = acc[ai][bj][m][0], v1 = acc[ai][bj][m][1];
                    u32x4 w; w.x = cvt_pk_bf16(v0[0], v0[1]); w.y = cvt_pk_bf16(v0[2], v0[3]); w.z = cvt_pk_bf16(v1[0], v1[1]); w.w = cvt_pk_bf16(v1[2], v1[3]);
                    *(u32x4*)(rowp + bj * HALF) = w; } }
    }
};
struct EpiResidStat {
    static constexpr bool PERM = false, AFTER_DRAIN = false;
    const float* base; float* out; int ldc; bf16_t* xb; float* rss;
    __device__ __forceinline__ void operator()(const f32x4 (&acc)[2][2][4][2], const Unit& u, int wr, int wc, int fr, int fq) const {
        const int col0 = u.pn * BM + wc * 32 + 4 * fq;
#pragma unroll
        for (int ai = 0; ai < 2; ++ai)
#pragma unroll
            for (int m = 0; m < 4; ++m) { const int row = u.pm * BM + ai * HALF + wr * 64 + m * 16 + fr; const size_t off = (size_t)row * ldc + col0; float ss = 0.f;
#pragma unroll
                for (int bj = 0; bj < 2; ++bj)
#pragma unroll
                    for (int n = 0; n < 2; ++n) { const f32x4 bs = *(const f32x4*)(base + off + bj * HALF + n * 16); const f32x4 o = bs + acc[ai][bj][m][n]; *(f32x4*)(out + off + bj * HALF + n * 16) = o;
                        unsigned long long pk = (unsigned long long)cvt_pk_bf16(o[0], o[1]) | ((unsigned long long)cvt_pk_bf16(o[2], o[3]) << 32); *(unsigned long long*)(xb + off + bj * HALF + n * 16) = pk;
                        ss += (o[0] * o[0] + o[1] * o[1]) + (o[2] * o[2] + o[3] * o[3]); }
                ss += __shfl_xor(ss, 16); ss += __shfl_xor(ss, 32);
                if (fq == 0) (void)__hip_atomic_fetch_add(rss + row, ss, __ATOMIC_RELAXED, __HIP_MEMORY_SCOPE_AGENT); }
    }
};
__device__ __forceinline__ float bf_lo(unsigned w) { return __builtin_bit_cast(float, w << 16); }
__device__ __forceinline__ float bf_hi(unsigned w) { return __builtin_bit_cast(float, w & 0xffff0000u); }
__device__ __forceinline__ void rowstat_add(float* rss, int row0, int fq, const float (&sv)[8]) {
#pragma unroll
    for (int t = 0; t < 2; ++t) { const float v = fq == 0 ? sv[t] : (fq == 1 ? sv[2 + t] : (fq == 2 ? sv[4 + t] : sv[6 + t])); const int blk = 2 * fq + t;
        (void)__hip_atomic_fetch_add(rss + row0 + (blk >> 2) * HALF + (blk & 3) * 16, v, __ATOMIC_RELAXED, __HIP_MEMORY_SCOPE_AGENT); }
}
struct EpiResidBfStat {
    static constexpr bool PERM = true, AFTER_DRAIN = false;
    bf16_t* xb; int ldc; float* rss;
    __device__ __forceinline__ void operator()(const f32x4 (&acc)[2][2][4][2], const Unit& u, int wr, int wc, int fr, int fq) const {
        const int row0 = u.pm * BM + wr * 64 + fr, col0 = u.pn * BM + wc * 32 + 8 * fq;
        float sv[8];
#pragma unroll
        for (int ai = 0; ai < 2; ++ai)
#pragma unroll
            for (int m = 0; m < 4; ++m) { const int row = row0 + ai * HALF + m * 16; bf16_t* rowp = xb + (size_t)row * ldc + col0; float ss = 0.f;
#pragma unroll
                for (int bj = 0; bj < 2; ++bj) { const u32x4 r = *(const u32x4*)(rowp + bj * HALF); f32x4 v0 = acc[ai][bj][m][0], v1 = acc[ai][bj][m][1];
                    v0[0] += bf_lo(r.x); v0[1] += bf_hi(r.x); v0[2] += bf_lo(r.y); v0[3] += bf_hi(r.y); v1[0] += bf_lo(r.z); v1[1] += bf_hi(r.z); v1[2] += bf_lo(r.w); v1[3] += bf_hi(r.w);
                    u32x4 w; w.x = cvt_pk_bf16(v0[0], v0[1]); w.y = cvt_pk_bf16(v0[2], v0[3]); w.z = cvt_pk_bf16(v1[0], v1[1]); w.w = cvt_pk_bf16(v1[2], v1[3]);
                    *(u32x4*)(rowp + bj * HALF) = w;
                    ss += ((v0[0] * v0[0] + v0[1] * v0[1]) + (v0[2] * v0[2] + v0[3] * v0[3])) + ((v1[0] * v1[0] + v1[1] * v1[1]) + (v1[2] * v1[2] + v1[3] * v1[3])); }
                ss += __shfl_xor(ss, 16); ss += __shfl_xor(ss, 32);
                sv[ai * 4 + m] = ss; }
        rowstat_add(rss, row0, fq, sv);
    }
};
struct EpiResidBfOut {
    static constexpr bool PERM = true, AFTER_DRAIN = false;
    const bf16_t* xb; float* out; int ldc;
    __device__ __forceinline__ void operator()(const f32x4 (&acc)[2][2][4][2], const Unit& u, int wr, int wc, int fr, int fq) const {
        const int row0 = u.pm * BM + wr * 64 + fr, col0 = u.pn * BM + wc * 32 + 8 * fq;
#pragma unroll
        for (int ai = 0; ai < 2; ++ai)
#pragma unroll
            for (int m = 0; m < 4; ++m) { const size_t off = (size_t)(row0 + ai * HALF + m * 16) * ldc + col0;
#pragma unroll
                for (int bj = 0; bj < 2; ++bj) { const u32x4 r = *(const u32x4*)(xb + off + bj * HALF); f32x4 v0 = acc[ai][bj][m][0], v1 = acc[ai][bj][m][1];
                    v0[0] += bf_lo(r.x); v0[1] += bf_hi(r.x); v0[2] += bf_lo(r.y); v0[3] += bf_hi(r.y); v1[0] += bf_lo(r.z); v1[1] += bf_hi(r.z); v1[2] += bf_lo(r.w); v1[3] += bf_hi(r.w);
                    *(f32x4*)(out + off + bj * HALF) = v0; *(f32x4*)(out + off + bj * HALF + 4) = v1; } }
    }
};
struct EpiFinalNorm {
    static constexpr bool PERM = true, AFTER_DRAIN = false;
    const bf16_t* xb; float* out; int ldc; float* rss; unsigned* cnt; const float* gain; float inv_k, eps; unsigned need;
    __device__ __forceinline__ void operator()(const f32x4 (&acc)[2][2][4][2], const Unit& u, int wr, int wc, int fr, int fq) const {
        const int row0 = u.pm * BM + wr * 64 + fr, col0 = u.pn * BM + wc * 32 + 8 * fq;
        float sv[8];
#pragma unroll
        for (int ai = 0; ai < 2; ++ai)
#pragma unroll
            for (int m = 0; m < 4; ++m) { const int row = row0 + ai * HALF + m * 16; const bf16_t* rowp = xb + (size_t)row * ldc + col0; float ss = 0.f;
#pragma unroll
                for (int bj = 0; bj < 2; ++bj) { const u32x4 r = *(const u32x4*)(rowp + bj * HALF); f32x4 v0 = acc[ai][bj][m][0], v1 = acc[ai][bj][m][1];
                    v0[0] += bf_lo(r.x); v0[1] += bf_hi(r.x); v0[2] += bf_lo(r.y); v0[3] += bf_hi(r.y); v1[0] += bf_lo(r.z); v1[1] += bf_hi(r.z); v1[2] += bf_lo(r.w); v1[3] += bf_hi(r.w);
                    ss += ((v0[0] * v0[0] + v0[1] * v0[1]) + (v0[2] * v0[2] + v0[3] * v0[3])) + ((v1[0] * v1[0] + v1[1] * v1[1]) + (v1[2] * v1[2] + v1[3] * v1[3])); }
                ss += __shfl_xor(ss, 16); ss += __shfl_xor(ss, 32);
                sv[ai * 4 + m] = ss; }
        rowstat_add(rss, row0, fq, sv);
        asm volatile("s_waitcnt vmcnt(0)\n\ts_barrier" ::: "memory");
        if (wr == 0 && wc == 0 && fr == 0 && fq == 0) {
            (void)__hip_atomic_fetch_add(cnt + u.pm, 1u, __ATOMIC_RELEASE, __HIP_MEMORY_SCOPE_AGENT);
            while (__hip_atomic_load(cnt + u.pm, __ATOMIC_ACQUIRE, __HIP_MEMORY_SCOPE_AGENT) < need) __builtin_amdgcn_s_sleep(1);
        }
        asm volatile("s_barrier" ::: "memory");
#pragma unroll
        for (int ai = 0; ai < 2; ++ai)
#pragma unroll
            for (int m = 0; m < 4; ++m) { const int row = row0 + ai * HALF + m * 16; const size_t off = (size_t)row * ldc + col0;
                const float rs = __builtin_amdgcn_rsqf(__hip_atomic_load(rss + row, __ATOMIC_RELAXED, __HIP_MEMORY_SCOPE_AGENT) * inv_k + eps);
#pragma unroll
                for (int bj = 0; bj < 2; ++bj) { const u32x4 r = *(const u32x4*)(xb + off + bj * HALF); f32x4 v0 = acc[ai][bj][m][0], v1 = acc[ai][bj][m][1];
                    v0[0] += bf_lo(r.x); v0[1] += bf_hi(r.x); v0[2] += bf_lo(r.y); v0[3] += bf_hi(r.y); v1[0] += bf_lo(r.z); v1[1] += bf_hi(r.z); v1[2] += bf_lo(r.w); v1[3] += bf_hi(r.w);
                    const f32x4 g0 = *(const f32x4*)(gain + col0 + bj * HALF), g1 = *(const f32x4*)(gain + col0 + bj * HALF + 4);
                    *(f32x4*)(out + off + bj * HALF) = v0 * rs * g0; *(f32x4*)(out + off + bj * HALF + 4) = v1 * rs * g1; } }
    }
};
struct EpiResid {
    static constexpr bool PERM = false, AFTER_DRAIN = false;
    const float* base; float* out; int ldc;
    __device__ __forceinline__ void operator()(const f32x4 (&acc)[2][2][4][2], const Unit& u, int wr, int wc, int fr, int fq) const {
        const int col0 = u.pn * BM + wc * 32 + 4 * fq;
#pragma unroll
        for (int ai = 0; ai < 2; ++ai)
#pragma unroll
            for (int m = 0; m < 4; ++m) { const size_t off = (size_t)(u.pm * BM + ai * HALF + wr * 64 + m * 16 + fr) * ldc + col0;
#pragma unroll
                for (int bj = 0; bj < 2; ++bj)
#pragma unroll
                    for (int n = 0; n < 2; ++n) { const f32x4 bs = *(const f32x4*)(base + off + bj * HALF + n * 16); *(f32x4*)(out + off + bj * HALF + n * 16) = bs + acc[ai][bj][m][n]; } }
    }
};
__device__ __forceinline__ float dpp_shr1(float oldv, float src) { return __builtin_bit_cast(float, __builtin_amdgcn_update_dpp(__builtin_bit_cast(int, oldv), __builtin_bit_cast(int, src), 0x111, 0xf, 0xf, false)); }
__device__ __forceinline__ float dpp_shr2(float oldv, float src) { return __builtin_bit_cast(float, __builtin_amdgcn_update_dpp(__builtin_bit_cast(int, oldv), __builtin_bit_cast(int, src), 0x112, 0xf, 0xf, false)); }
__device__ __forceinline__ float dpp_ror1(float src) { return __builtin_bit_cast(float, __builtin_amdgcn_mov_dpp(__builtin_bit_cast(int, src), 0x121, 0xf, 0xf, false)); }
__device__ __forceinline__ float dpp_ror2(float src) { return __builtin_bit_cast(float, __builtin_amdgcn_mov_dpp(__builtin_bit_cast(int, src), 0x122, 0xf, 0xf, false)); }
struct EpiConvGate {
    static constexpr bool PERM = true, AFTER_DRAIN = false;
    bf16_t* ACT; int ldact; const float* cw; int nch  ; float* HB; int npn; PG8_LAS float* halo;
    const float* rss; float inv_k, eps;
    __device__ __forceinline__ void operator()(const f32x4 (&acc)[2][2][4][2], const Unit& u, int wr, int wc, int fr, int fq) const {
        const int ch0 = u.pn * 128 + wc * 32 + 8 * fq;
        float rs[2][4]; rstd_rows(rss, u.pm * BM + wr * 64 + fr, inv_k, eps, rs);
        int frh = fr, fqh = fq; asm volatile("" : "+v"(frh), "+v"(fqh));

        float wg[3][8], wu[3][8];
#pragma unroll
        for (int tap = 0; tap < 3; ++tap) { const f32x4 a0 = *(const f32x4*)(cw + (size_t)tap * 2 * nch + ch0), a1 = *(const f32x4*)(cw + (size_t)tap * 2 * nch + ch0 + 4), b0 = *(const f32x4*)(cw + (size_t)tap * 2 * nch + nch + ch0), b1 = *(const f32x4*)(cw + (size_t)tap * 2 * nch + nch + ch0 + 4);
            wg[tap][0] = a0[0]; wg[tap][1] = a0[1]; wg[tap][2] = a0[2]; wg[tap][3] = a0[3]; wg[tap][4] = a1[0]; wg[tap][5] = a1[1]; wg[tap][6] = a1[2]; wg[tap][7] = a1[3];
            wu[tap][0] = b0[0]; wu[tap][1] = b0[1]; wu[tap][2] = b0[2]; wu[tap][3] = b0[3]; wu[tap][4] = b1[0]; wu[tap][5] = b1[1]; wu[tap][6] = b1[2]; wu[tap][7] = b1[3]; }
        const int hcol = (wc * 4 + fq) * 8;
        if (fr >= 14) {
#pragma unroll
            for (int ai = 0; ai < 2; ++ai)
#pragma unroll
                for (int bj = 0; bj < 2; ++bj) { PG8_LAS float* hp = halo + (((2 * ai + wr) * 2 + (fr - 14)) * 2 + bj) * 128 + hcol;
                    *(PG8_LAS f32x4*)hp = acc[ai][bj][3][0] * rs[ai][3]; *(PG8_LAS f32x4*)(hp + 4) = acc[ai][bj][3][1] * rs[ai][3]; }
            if (wr == 1) { float* hb = HB + ((size_t)(u.pm * npn + u.pn) * 4 + 2 + (frh - 14)) * 256 + wc * 32 + 8 * fqh;
#pragma unroll
                for (int bj = 0; bj < 2; ++bj) { *(f32x4*)(hb + bj * 128) = acc[1][bj][3][0] * rs[1][3]; *(f32x4*)(hb + bj * 128 + 4) = acc[1][bj][3][1] * rs[1][3]; } }
        }
        if (fr < 2 && wr == 0) { float* hb = HB + ((size_t)(u.pm * npn + u.pn) * 4 + frh) * 256 + wc * 32 + 8 * fqh;
#pragma unroll
            for (int bj = 0; bj < 2; ++bj) { *(f32x4*)(hb + bj * 128) = acc[0][bj][0][0] * rs[0][0]; *(f32x4*)(hb + bj * 128 + 4) = acc[0][bj][0][1] * rs[0][0]; } }
        asm volatile("s_waitcnt lgkmcnt(0)\n\ts_barrier" ::: "memory");
#pragma unroll
        for (int ai = 0; ai < 2; ++ai) {
            const int seg = 2 * ai + wr;
            float p1o[2][8], p2o[2][8];
#pragma unroll
            for (int bj = 0; bj < 2; ++bj) {
                if (seg > 0) { const PG8_LAS float* h1 = halo + (((seg - 1) * 2 + 1) * 2 + bj) * 128 + hcol; const PG8_LAS float* h2 = halo + (((seg - 1) * 2 + (fr & 1)) * 2 + bj) * 128 + hcol;
                    const f32x4 a = *(const PG8_LAS f32x4*)h1, b = *(const PG8_LAS f32x4*)(h1 + 4), c = *(const PG8_LAS f32x4*)h2, d = *(const PG8_LAS f32x4*)(h2 + 4);
#pragma unroll
                    for (int i = 0; i < 4; ++i) { p1o[bj][i] = a[i]; p1o[bj][4 + i] = b[i]; p2o[bj][i] = c[i]; p2o[bj][4 + i] = d[i]; }
                } else {
#pragma unroll
                    for (int i = 0; i < 8; ++i) { p1o[bj][i] = 0.f; p2o[bj][i] = 0.f; } }
            }
#pragma unroll
            for (int m = 0; m < 4; ++m) {
                float o[8], gcv[8], ucv[8];
#pragma unroll
                for (int i = 0; i < 8; ++i) {
                    const float xg = acc[ai][0][m][i >> 2][i & 3] * rs[ai][m], xu = acc[ai][1][m][i >> 2][i & 3] * rs[ai][m];
                    float og1, og2, ou1, ou2;
                    if (m == 0) { og1 = p1o[0][i]; og2 = p2o[0][i]; ou1 = p1o[1][i]; ou2 = p2o[1][i]; }
                    else { const float pg = acc[ai][0][m - 1][i >> 2][i & 3] * rs[ai][m - 1], pu = acc[ai][1][m - 1][i >> 2][i & 3] * rs[ai][m - 1]; og1 = dpp_ror1(pg); og2 = dpp_ror2(pg); ou1 = dpp_ror1(pu); ou2 = dpp_ror2(pu); }
                    const float g1 = dpp_shr1(og1, xg), g2 = dpp_shr2(og2, xg), u1 = dpp_shr1(ou1, xu), u2 = dpp_shr2(ou2, xu);
                    const float gc = wg[0][i] * g2 + wg[1][i] * g1 + wg[2][i] * xg, uc = wu[0][i] * u2 + wu[1][i] * u1 + wu[2][i] * xu;
                    gcv[i] = gc; ucv[i] = uc;
                }
#pragma unroll
                for (int i = 0; i < 8; i += 2) {
                    typedef float f32x2v __attribute__((ext_vector_type(2)));
                    const f32x2v g2v = {gcv[i], gcv[i + 1]}, u2v = {ucv[i], ucv[i + 1]};
                    const f32x2v t = g2v * -1.4426950408889634f;
                    f32x2v ex = {__builtin_amdgcn_exp2f(t[0]), __builtin_amdgcn_exp2f(t[1])};
                    ex = ex + 1.f;
                    const f32x2v rc = {__builtin_amdgcn_rcpf(ex[0]), __builtin_amdgcn_rcpf(ex[1])};
                    const f32x2v ov = g2v * rc * u2v;
                    o[i] = ov[0]; o[i + 1] = ov[1];
                }
                u32x4 w; w.x = cvt_pk_bf16(o[0], o[1]); w.y = cvt_pk_bf16(o[2], o[3]); w.z = cvt_pk_bf16(o[4], o[5]); w.w = cvt_pk_bf16(o[6], o[7]);
                *(u32x4*)(ACT + (size_t)(u.pm * BM + ai * HALF + wr * 64 + m * 16 + fr) * ldact + ch0) = w;
            }
        }
    }
};
template <class Epi, class Sched, bool ALIGN_EPI = false, bool SP2 = false>
__device__ __forceinline__ void gemm_phase(PG8_LAS unsigned char* lds, const Gemm g, const Sched& S, const Epi& E) {
    const int tid = tid_local(), wid = __builtin_amdgcn_readfirstlane(tid >> 6), lane = tid & 63, wr = wid >> 2, wc = wid & 3, fr = lane & 15, fq = lane >> 4;
    const int K = g.K, nt = K / BK;
    unsigned voffA[2], voffB[2];
#pragma unroll
    for (int i = 0; i < 2; ++i) { int R, C; stage_rc(tid * 16 + i * 8192, R, C); const int Rb = Epi::PERM ? ((R & ~31) + perm32(R & 31)) : R;
        voffA[i] = (unsigned)(R * K + C) * 2u; voffB[i] = (unsigned)(Rb * K + C) * 2u; }
    const size_t kstep = (size_t)(BK * 2);
    const size_t hstep = (size_t)HALF * K * 2;
    const size_t tstep = 2 * hstep;
    const unsigned ldsw = (unsigned)wid * 1024u;
    const int aoff = lds_byte(wr * 64 + fr, fq * 8), boff = lds_byte(wc * 32 + fr, fq * 8);
#define PG8_SA(b, h) (((b) * 2 + (h)) * HTB)
#define PG8_SB(b, h) ((4 + (b) * 2 + (h)) * HTB)
#define PG8_STAGE(bufoff, gbase, voff) do { _Pragma("unroll") for (int _i = 0; _i < 2; ++_i) \
        __builtin_amdgcn_global_load_lds((const unsigned*)((const char*)(gbase) + (voff)[_i]), (PG8_LAS unsigned*)(lds + (bufoff) + ldsw + _i * 8192), 16, 0, 0); } while (0)
#define PG8_LDA(dst, b, h) do { _Pragma("unroll") for (int m = 0; m < 4; ++m) _Pragma("unroll") for (int k = 0; k < 2; ++k) dst[m][k] = *(const PG8_LAS bf16x8*)(lds + PG8_SA(b, h) + aoff + m * 2048 + k * 1024); } while (0)
#define PG8_LDB(dst, b, h) do { _Pragma("unroll") for (int n = 0; n < 2; ++n) _Pragma("unroll") for (int k = 0; k < 2; ++k) dst[n][k] = *(const PG8_LAS bf16x8*)(lds + PG8_SB(b, h) + boff + n * 2048 + k * 1024); } while (0)
#define PG8_MMA(ai, bj, At, Bt) do { __builtin_amdgcn_s_setprio(1); _Pragma("unroll") for (int m = 0; m < 4; ++m) _Pragma("unroll") for (int n = 0; n < 2; ++n) _Pragma("unroll") for (int k = 0; k < 2; ++k) \
        acc[ai][bj][m][n] = __builtin_amdgcn_mfma_f32_16x16x32_bf16(Bt[n][k], At[m][k], acc[ai][bj][m][n], 0, 0, 0); __builtin_amdgcn_s_setprio(0); } while (0)
#define PG8_WAIT_V(n) asm volatile("s_waitcnt vmcnt(" #n ")" ::: "memory")
#define PG8_WAIT_L(n) asm volatile("s_waitcnt lgkmcnt(" #n ")" ::: "memory")
#define PG8_BAR __builtin_amdgcn_s_barrier()
#define PG8_SCHED __builtin_amdgcn_sched_barrier(0)
    Unit cur, nxt; int ui = 0;
    if (!S.next(0, cur)) return;
    f32x4 acc[2][2][4][2];
#pragma unroll
    for (int a = 0; a < 2; ++a)
#pragma unroll
        for (int b = 0; b < 2; ++b)
#pragma unroll
            for (int m = 0; m < 4; ++m)
#pragma unroll
                for (int n = 0; n < 2; ++n) acc[a][b][m][n] = (f32x4){0.f, 0.f, 0.f, 0.f};
    bf16x8 At[4][2], B0[2][2], B1[2][2];
    const char* cA = (const char*)g.A + (size_t)cur.pm * tstep; const char* cB = (const char*)g.Bt + (size_t)cur.pn * tstep;
    S.a_ready(cur);
    if constexpr (SP2) {
        PG8_STAGE(PG8_SB(0, 0), cB, voffB); PG8_STAGE(PG8_SB(0, 1), cB + hstep, voffB); PG8_STAGE(PG8_SA(0, 0), cA, voffA); PG8_STAGE(PG8_SA(0, 1), cA + hstep, voffA);
        if (wr == 1) PG8_BAR;
        PG8_WAIT_V(2); PG8_BAR;
        PG8_STAGE(PG8_SB(1, 0), cB + kstep, voffB); PG8_STAGE(PG8_SA(1, 0), cA + kstep, voffA); PG8_STAGE(PG8_SB(1, 1), cB + hstep + kstep, voffB);
        PG8_WAIT_V(6); PG8_BAR;
    } else {
        PG8_STAGE(PG8_SB(0, 0), cB, voffB); PG8_STAGE(PG8_SA(0, 0), cA, voffA); PG8_STAGE(PG8_SB(0, 1), cB + hstep, voffB); PG8_STAGE(PG8_SA(0, 1), cA + hstep, voffA);
        if (wr == 1) PG8_BAR;
        PG8_WAIT_V(4); PG8_BAR;
        PG8_STAGE(PG8_SB(1, 0), cB + kstep, voffB); PG8_STAGE(PG8_SA(1, 0), cA + kstep, voffA); PG8_STAGE(PG8_SB(1, 1), cB + hstep + kstep, voffB);
        PG8_WAIT_V(6); PG8_BAR;
    }
    for (;;) {
        const bool has_next = S.next(ui + 1, nxt);
        const char* nA = has_next ? (const char*)g.A + (size_t)nxt.pm * tstep : cA; const char* nB = has_next ? (const char*)g.Bt + (size_t)nxt.pn * tstep : cB;
        for (int t = 0; t < nt; t += 2) {
            const bool last = (t == nt - 2);
            const char* a1 = cA + (size_t)(t + 1) * kstep;
            const char* a2 = last ? nA : cA + (size_t)(t + 2) * kstep; const char* b2 = last ? nB : cB + (size_t)(t + 2) * kstep;
            const char* a3 = a2 + kstep; const char* b3 = b2 + kstep;
            if (last && has_next) S.a_ready(nxt);
            if constexpr (SP2) {
            PG8_LDB(B0, 0, 0); PG8_LDB(B1, 0, 1); PG8_SCHED; PG8_LDA(At, 0, 0); PG8_STAGE(PG8_SA(1, 1), a1 + hstep, voffA);
            PG8_WAIT_V(8); PG8_WAIT_L(0); PG8_BAR; PG8_MMA(0, 0, At, B0); PG8_MMA(0, 1, At, B1); PG8_BAR; PG8_SCHED;
            PG8_LDA(At, 0, 1); PG8_STAGE(PG8_SB(0, 0), b2, voffB); PG8_STAGE(PG8_SB(0, 1), b2 + hstep, voffB); PG8_STAGE(PG8_SA(0, 0), a2, voffA);
            PG8_WAIT_V(8); PG8_WAIT_L(0); PG8_BAR; PG8_MMA(1, 0, At, B0); PG8_MMA(1, 1, At, B1); PG8_BAR; PG8_SCHED;
            PG8_LDB(B0, 1, 0); PG8_LDB(B1, 1, 1); PG8_SCHED; PG8_LDA(At, 1, 0); PG8_STAGE(PG8_SA(0, 1), a2 + hstep, voffA);
            PG8_WAIT_V(8); PG8_WAIT_L(0); PG8_BAR; PG8_MMA(0, 0, At, B0); PG8_MMA(0, 1, At, B1); PG8_BAR; PG8_SCHED;
            PG8_LDA(At, 1, 1); PG8_STAGE(PG8_SB(1, 0), b3, voffB); PG8_STAGE(PG8_SB(1, 1), b3 + hstep, voffB); PG8_STAGE(PG8_SA(1, 0), a3, voffA);
            PG8_WAIT_V(8); PG8_WAIT_L(0); PG8_BAR; PG8_MMA(1, 0, At, B0); PG8_MMA(1, 1, At, B1); PG8_BAR; PG8_SCHED;
            } else {
            PG8_LDB(B0, 0, 0); PG8_SCHED; PG8_LDA(At, 0, 0); PG8_STAGE(PG8_SA(1, 1), a1 + hstep, voffA);
            PG8_WAIT_L(8); PG8_BAR; PG8_WAIT_L(0); PG8_MMA(0, 0, At, B0); PG8_BAR; PG8_SCHED;
            PG8_LDB(B1, 0, 1); PG8_STAGE(PG8_SB(0, 0), b2, voffB);
            PG8_BAR; PG8_WAIT_L(0); PG8_MMA(0, 1, At, B1); PG8_BAR;
            PG8_LDA(At, 0, 1); PG8_STAGE(PG8_SA(0, 0), a2, voffA);
            PG8_BAR; PG8_WAIT_L(0); PG8_MMA(1, 0, At, B0); PG8_BAR; PG8_SCHED;
            PG8_STAGE(PG8_SB(0, 1), b2 + hstep, voffB);
            PG8_WAIT_V(6); PG8_BAR; PG8_MMA(1, 1, At, B1); PG8_BAR;
            PG8_LDB(B0, 1, 0); PG8_SCHED; PG8_LDA(At, 1, 0); PG8_STAGE(PG8_SA(0, 1), a2 + hstep, voffA);
            PG8_WAIT_L(8); PG8_BAR; PG8_WAIT_L(0); PG8_MMA(0, 0, At, B0); PG8_BAR; PG8_SCHED;
            PG8_LDB(B1, 1, 1); PG8_STAGE(PG8_SB(1, 0), b3, voffB);
            PG8_BAR; PG8_WAIT_L(0); PG8_MMA(0, 1, At, B1); PG8_BAR;
            PG8_LDA(At, 1, 1); PG8_STAGE(PG8_SA(1, 0), a3, voffA);
            PG8_BAR; PG8_WAIT_L(0); PG8_MMA(1, 0, At, B0); PG8_BAR; PG8_SCHED;
            PG8_STAGE(PG8_SB(1, 1), b3 + hstep, voffB);
            PG8_WAIT_V(6); PG8_BAR; PG8_MMA(1, 1, At, B1); PG8_BAR;
            }
        }
        if constexpr (ALIGN_EPI) { if (wr == 0) PG8_BAR; }
        if constexpr (!Epi::AFTER_DRAIN) { E(acc, cur, wr, wc, fr, fq); S.done(cur); }
        if (!has_next) break;
#pragma unroll
        for (int a = 0; a < 2; ++a)
#pragma unroll
            for (int b = 0; b < 2; ++b)
#pragma unroll
                for (int m = 0; m < 4; ++m)
#pragma unroll
                    for (int n = 0; n < 2; ++n) acc[a][b][m][n] = (f32x4){0.f, 0.f, 0.f, 0.f};
        cur = nxt; cA = nA; cB = nB; ++ui;
        if constexpr (ALIGN_EPI) { if (wr == 1) PG8_BAR; }
    }
    PG8_WAIT_V(0);
    if constexpr (!ALIGN_EPI) { if (wr == 0) PG8_BAR; }
    PG8_BAR;
    if constexpr (Epi::AFTER_DRAIN) { E.fused(acc, cur, wr, wc, fr, fq, lds, wid, lane); S.done(cur); }
#undef PG8_SA
#undef PG8_SB
#undef PG8_STAGE
#undef PG8_LDA
#undef PG8_LDB
#undef PG8_MMA
#undef PG8_WAIT_V
#undef PG8_WAIT_L
#undef PG8_BAR
#undef PG8_SCHED
}
}
constexpr int NWAVES = 8, NTHR = 512;
constexpr int BATCH = 4, SEQ = 4096, DM = 4096, M = BATCH * SEQ, DEPTH = 2;
constexpr int POOL_DIM = 1024, ATTN_DIM = 1536, GDN_DIM = 1536, NH = 12, HD = 128;
constexpr int IN_DIM = 11812, NPROJ = 12032  , PQ = 11776  ;
constexpr int FFN = 11008, FFN2 = 22016;
constexpr int C_POOL = 0, C_FQ = 1024, C_FK = 2560, C_FV = 4096, C_GQ = 5632, C_GK = 7168, C_GV = 8704, C_GZ = 10240, PN_SMALL = 46;
constexpr int SM_FF = 0, SM_GB = 12, SM_GA = 24;
constexpr float EPS = 1e-6f;
constexpr int NCHUNK = SEQ / 64;
constexpr int NUNIT_GDN = BATCH * NH * NCHUNK;

constexpr size_t MiB = 1u << 20;
constexpr size_t WS_CTL = 0, CTL_ZERO_BYTES = 1 * MiB, WS_RN2 = 1 * MiB;
constexpr size_t SZ_WIN = (size_t)NPROJ * DM * 2, SZ_WO = (size_t)DM * DM * 2, SZ_WUP = (size_t)FFN2 * DM * 2, SZ_WDN = (size_t)DM * FFN * 2, SZ_PW = (size_t)4 * 256 * 256 * 2;
constexpr size_t WS_WIN = 4 * MiB, WS_WO = WS_WIN + 2 * SZ_WIN, WS_WUP = WS_WO + 2 * SZ_WO, WS_WDN = WS_WUP + 2 * SZ_WUP, WS_PW = WS_WDN + 2 * SZ_WDN;
constexpr size_t WS_XN = ((WS_PW + 2 * SZ_PW + MiB - 1) / MiB) * MiB;
constexpr size_t WS_X = WS_XN + (size_t)M * DM * 2;
constexpr size_t WS_OV = WS_X + (size_t)M * DM * 4;
constexpr size_t WS_PROJ = WS_OV, WS_SMALL = WS_PROJ + (size_t)M * PQ * 2, WS_MIX = WS_SMALL + (size_t)M * 64 * 4;
constexpr size_t WS_NEGW = WS_MIX + (size_t)M * DM * 2;
constexpr size_t WS_QDEC = WS_NEGW + (size_t)NUNIT_GDN * 8192 * 2;
constexpr size_t WS_KDT = WS_QDEC + (size_t)NUNIT_GDN * 8192 * 2;
constexpr size_t WS_INTRA = WS_KDT + (size_t)NUNIT_GDN * 8192 * 2;
constexpr size_t WS_UT = WS_INTRA + (size_t)NUNIT_GDN * 4096 * 2;
constexpr size_t WS_EGL = WS_UT + (size_t)NUNIT_GDN * 8192 * 4;
constexpr size_t WS_NCK = WS_EGL + 16384;
constexpr size_t WS_OV_END1 = WS_NCK + (size_t)BATCH * NH * SEQ * 4;
constexpr size_t WS_U = WS_OV;
constexpr size_t WS_OV_END2 = WS_U + (size_t)M * FFN2 * 2;
constexpr size_t WS_ACT = ((((WS_OV_END1 > WS_OV_END2) ? WS_OV_END1 : WS_OV_END2) + MiB - 1) / MiB) * MiB;
constexpr size_t WS_HB = WS_ACT + (size_t)M * FFN * 2;
constexpr size_t WS_JLO = WS_HB + (size_t)(M / 256) * (FFN2 / 256) * 4 * 256 * 4;
constexpr size_t WS_END = WS_JLO + 4096;
static_assert(WS_END <= (size_t)2752 * MiB, "d_ws map exceeds the guaranteed workspace");

constexpr int CW_TMO = 0, CW_CODE = 1, CW_BAR = 4096, CW_Q = 8192, CW_BG = 8192 + 1024, CW_FN = 12288  , CW_BND = 13312  , CW_RS = 16384;

constexpr int RING_BYTES = 146432, LDSCTL_OFF = RING_BYTES, MISC_OFF = LDSCTL_OFF + 320, LDS_BYTES = 147456;
namespace fox {
typedef unsigned short bf16;
typedef short bf16x8 __attribute__((ext_vector_type(8)));
typedef short s16x4 __attribute__((ext_vector_type(4)));
typedef float f32x16 __attribute__((ext_vector_type(16)));
typedef float f32x4 __attribute__((ext_vector_type(4)));
typedef unsigned u32x4 __attribute__((ext_vector_type(4)));
typedef __attribute__((address_space(3))) char lchar;
constexpr int D = 128, NW = 8, QBLK = 32, KVBLK = 64, QB = NW * QBLK;
constexpr int SHM_V = KVBLK * D * 2, SHM_K = KVBLK * D * 2;
constexpr int OFF_WS = 2 * SHM_V + 2 * SHM_K, OFF_CK = OFF_WS + NW * 64 * 4, OFF_Q = OFF_CK + 2 * 64 * 4, LDS_BYTES = OFF_Q + NW * 8192;
constexpr float SCALE = 0.08838834764831845f;
constexpr float THR = 8.f;
#define FOX_KSWZ(row, colB) ((row) * 256 + ((colB) ^ (((row) & 7) << 4)))
#define FOX_SBAR() __builtin_amdgcn_sched_barrier(0)
__device__ __forceinline__ int v_st(int k, int c) { const int kk = (k & ~0xC) | ((k & 4) << 1) | ((k & 8) >> 1); return ((kk >> 3) * 4 + (c >> 5)) * 512 + ((kk & 7) * 32 + (c & 31)) * 2; }
__device__ __forceinline__ int v_rd_base(int lane) { return ((lane & 3) << 3) | (((lane >> 2) & 3) << 6) | (((lane >> 4) & 1) << 5) | (((lane >> 5) & 1) << 8); }
constexpr int v_rd_off(int d0, int ks, int half) { return d0 * 512 + ks * 4096 + half * 2048; }
__device__ __forceinline__ int crow(int r, int hi) { return (r & 3) + 8 * (r >> 2) + 4 * hi; }
__device__ __forceinline__ unsigned cvtpk(float lo, float hi) { return pg8::cvt_pk_bf16(lo, hi); }
__device__ __forceinline__ bf16x8 load8(const bf16* p) { return *reinterpret_cast<const bf16x8*>(p); }
__device__ __forceinline__ void mask_tile(f32x16& p0, f32x16& p1, int dq, unsigned W) {
    const float NEG = -__builtin_inff();
#pragma unroll
    for (int r = 0; r < 16; ++r) {
        const int c = (r & 3) + 8 * (r >> 2);
        if ((unsigned)(dq - c) >= W) p0[r] = NEG;
        if ((unsigned)(dq - c - 32) >= W) p1[r] = NEG;
    }
}
__device__ __forceinline__ void bias_tile(f32x16& p0, f32x16& p1, const lchar* ck, int hi) {
    const __attribute__((address_space(3))) float* c = (const __attribute__((address_space(3))) float*)ck + 4 * hi;
#pragma unroll
    for (int q = 0; q < 4; ++q) {
        const f32x4 a = *(const __attribute__((address_space(3))) f32x4*)(c + 8 * q), b = *(const __attribute__((address_space(3))) f32x4*)(c + 32 + 8 * q);
#pragma unroll
        for (int i = 0; i < 4; ++i) { p0[4 * q + i] += a[i]; p1[4 * q + i] += b[i]; }
    }
}
__device__ __forceinline__ void partialSM(f32x16& p0, f32x16& p1, float& m_reg, float& mn, float& alpha) {
    float pmax = p0[0];
#pragma unroll
    for (int r = 1; r < 16; ++r) pmax = fmaxf(pmax, p0[r]);
#pragma unroll
    for (int r = 0; r < 16; ++r) pmax = fmaxf(pmax, p1[r]);
    { auto rr = __builtin_amdgcn_permlane32_swap(__float_as_uint(pmax), __float_as_uint(pmax), false, false);
      pmax = fmaxf(__uint_as_float(rr[0]), __uint_as_float(rr[1])); }
    constexpr float C2 = 1.4426950408889634f * SCALE;
    if (__builtin_expect(__all((pmax - m_reg) * SCALE <= THR), 1)) { mn = m_reg; alpha = 1.f; }
    else { mn = fmaxf(m_reg, pmax); alpha = __builtin_amdgcn_exp2f((m_reg - mn) * C2); m_reg = mn; }
    const float mnL = -mn * C2;
#pragma unroll
    for (int r = 0; r < 16; ++r) p0[r] = fmaf(p0[r], C2, mnL);
#pragma unroll
    for (int r = 0; r < 16; ++r) p1[r] = fmaf(p1[r], C2, mnL);
#pragma unroll
    for (int r = 0; r < 16; ++r) p0[r] = __builtin_amdgcn_exp2f(p0[r]);
}
__device__ __forceinline__ void finishSM(f32x16& p0, f32x16& p1, float alpha, float& l_reg, bf16x8& pa0, bf16x8& pa1, bf16x8& pa2, bf16x8& pa3) {
#pragma unroll
    for (int r = 0; r < 16; ++r) p1[r] = __builtin_amdgcn_exp2f(p1[r]);
    float ps = 0;
#pragma unroll
    for (int r = 0; r < 16; ++r) ps += p0[r];
#pragma unroll
    for (int r = 0; r < 16; ++r) ps += p1[r];
    { auto rr = __builtin_amdgcn_permlane32_swap(__float_as_uint(ps), __float_as_uint(ps), false, false);
      ps = __uint_as_float(rr[0]) + __uint_as_float(rr[1]); }
    l_reg = l_reg * alpha + ps;
#define FOX_PK4(P, B_, OUT) do { unsigned a0 = cvtpk(P[B_+0], P[B_+1]), a1 = cvtpk(P[B_+2], P[B_+3]);                          \
        unsigned b0 = cvtpk(P[B_+4], P[B_+5]), b1 = cvtpk(P[B_+6], P[B_+7]);                                             \
        auto r0 = __builtin_amdgcn_permlane32_swap(a0, b0, false, false); auto r1 = __builtin_amdgcn_permlane32_swap(a1, b1, false, false); \
        u32x4 w = {r0[0], r1[0], r0[1], r1[1]}; OUT = __builtin_bit_cast(bf16x8, w); } while (0)
    FOX_PK4(p0, 0, pa0); FOX_PK4(p0, 8, pa1); FOX_PK4(p1, 0, pa2); FOX_PK4(p1, 8, pa3);
#undef FOX_PK4
}
template <int KB>
__device__ __forceinline__ void qkt(f32x16& p0, f32x16& p1, const lchar* K_lds, int r32, int hi, const lchar* qs) {
    p0 = f32x16{}; p1 = f32x16{};
    const lchar* kb[4];
#pragma unroll
    for (int dd = 0; dd < 4; ++dd) kb[dd] = K_lds + KB * SHM_K + FOX_KSWZ(r32, (dd * 16 + hi * 8) * 2);
#pragma unroll
    for (int d0 = 0; d0 < 8; ++d0) { const lchar* a = kb[d0 & 3] + (d0 >> 2) * 128;
        bf16x8 b0 = *reinterpret_cast<const __attribute__((address_space(3))) bf16x8*>(a);
        bf16x8 b1 = *reinterpret_cast<const __attribute__((address_space(3))) bf16x8*>(a + 32 * 256);
        const bf16x8 qf = *reinterpret_cast<const __attribute__((address_space(3))) bf16x8*>(qs + d0 * 1024);
        p0 = __builtin_amdgcn_mfma_f32_32x32x16_bf16(b0, qf, p0, 0, 0, 0);
        p1 = __builtin_amdgcn_mfma_f32_32x32x16_bf16(b1, qf, p1, 0, 0, 0); }
}
template <int VB>
__device__ __forceinline__ void pv_tile(f32x16* o, int vb0, bf16x8 pa0, bf16x8 pa1, bf16x8 pa2, bf16x8 pa3) {
#define FOX_TRRD(dst, off) asm volatile("ds_read_b64_tr_b16 %0, %1 offset:%2" : "=&v"(dst) : "v"(vb0), "i"(off) : "memory")
#define FOX_PV_D0(d0) do { s16x4 l0, l1, l2, l3, h0, h1, h2, h3; constexpr int b_ = VB * SHM_V + v_rd_off(d0, 0, 0); \
        FOX_TRRD(l0, b_); FOX_TRRD(h0, b_ + 2048); FOX_TRRD(l1, b_ + 4096); FOX_TRRD(h1, b_ + 6144); FOX_TRRD(l2, b_ + 8192); FOX_TRRD(h2, b_ + 10240); FOX_TRRD(l3, b_ + 12288); FOX_TRRD(h3, b_ + 14336); \
        asm volatile("s_waitcnt lgkmcnt(0)" ::: "memory"); FOX_SBAR();   \
        o[d0] = __builtin_amdgcn_mfma_f32_32x32x16_bf16(pa0, (bf16x8){l0[0], l0[1], l0[2], l0[3], h0[0], h0[1], h0[2], h0[3]}, o[d0], 0, 0, 0);   \
        o[d0] = __builtin_amdgcn_mfma_f32_32x32x16_bf16(pa1, (bf16x8){l1[0], l1[1], l1[2], l1[3], h1[0], h1[1], h1[2], h1[3]}, o[d0], 0, 0, 0);   \
        o[d0] = __builtin_amdgcn_mfma_f32_32x32x16_bf16(pa2, (bf16x8){l2[0], l2[1], l2[2], l2[3], h2[0], h2[1], h2[2], h2[3]}, o[d0], 0, 0, 0);   \
        o[d0] = __builtin_amdgcn_mfma_f32_32x32x16_bf16(pa3, (bf16x8){l3[0], l3[1], l3[2], l3[3], h3[0], h3[1], h3[2], h3[3]}, o[d0], 0, 0, 0); } while (0)
    FOX_PV_D0(0); FOX_PV_D0(1); FOX_PV_D0(2); FOX_PV_D0(3);
#undef FOX_PV_D0
#undef FOX_TRRD
}
struct BlockRef { const bf16* Q; const bf16* K; const bf16* V; bf16* O; const float* NCK; int P0; int jlo; };
struct Ctx { const bf16* PROJ; bf16* MIX; const float* NCK; unsigned* qc; unsigned first, end; __attribute__((address_space(3))) unsigned* slot; const __attribute__((address_space(3))) int* jl; };
__device__ __forceinline__ BlockRef item_ref(const Ctx& c, unsigned idx) {
    const unsigned a = idx - c.first; const int qb = (SEQ / QB - 1) - (int)(a / (unsigned)(BATCH * NH)), bh = (int)(a % (unsigned)(BATCH * NH)), b = bh / NH, h = bh % NH; BlockRef r;
    const bf16* base = c.PROJ + (size_t)(b * SEQ) * PQ + h * HD;
    r.Q = base + (size_t)(qb * QB) * PQ + C_FQ; r.K = base + C_FK; r.V = base + C_FV;
    r.O = c.MIX + (size_t)(b * SEQ + qb * QB) * DM + POOL_DIM + h * HD; r.NCK = c.NCK + (size_t)bh * SEQ; r.P0 = qb * QB; r.jlo = __builtin_amdgcn_readfirstlane(c.jl[bh * (SEQ / QB) + qb]);
    return r;
}
struct Seam { bf16x8 qr[8]; bf16x8 st_v0, st_v1, st_k0, st_k1; };
#define FOX_ROW(p, k0, rr) ((p) + (size_t)((k0) + (rr)) * PQ + sc)
#define FOX_VMW() asm volatile("s_waitcnt vmcnt(0)" ::: "memory")
#define FOX_VMWN(n) asm volatile("s_waitcnt vmcnt(%0)" :: "i"(n) : "memory")
#define FOX_SLOAD(Kp, Vp, Cp, k0, cb) do { S.st_v0 = load8(FOX_ROW(Vp, k0, sr)); S.st_v1 = load8(FOX_ROW(Vp, k0, 32 + sr));              \
                         S.st_k0 = load8(FOX_ROW(Kp, k0, sr)); S.st_k1 = load8(FOX_ROW(Kp, k0, 32 + sr)); \
                         if (wid == 0) __builtin_amdgcn_global_load_lds((const unsigned*)((Cp) + (k0) + lane), (__attribute__((address_space(3))) unsigned*)(CK_lds + (cb) * 64), 4, 0, 0); } while (0)
#define FOX_SWRITE_K(bf) do { *(__attribute__((address_space(3))) bf16x8*)(K_lds + (bf) * SHM_K + kws) = S.st_k0; *(__attribute__((address_space(3))) bf16x8*)(K_lds + (bf) * SHM_K + kws + 32 * 256) = S.st_k1; \
                              } while (0)
#define FOX_SWRITE_V(bf) do { *(__attribute__((address_space(3))) bf16x8*)(V_lds + (bf) * SHM_V + vst0) = S.st_v0; *(__attribute__((address_space(3))) bf16x8*)(V_lds + (bf) * SHM_V + vst1) = S.st_v1; } while (0)
#define FOX_SWRITE(bf) do { FOX_SWRITE_V(bf); FOX_SWRITE_K(bf); } while (0)
template <int PO>
__device__ __forceinline__ void fox_prime(const BlockRef& cur, lchar* lds, Seam& S) {
    const int tid = tid_local(), wid = __builtin_amdgcn_readfirstlane(tid >> 6), lane = tid & 63, r32 = lane & 31, hi = lane >> 5;
    const int sr = tid >> 4, sc = (tid & 15) * 8, kws = FOX_KSWZ(sr, sc * 2); lchar* K_lds = lds + 2 * SHM_V;
    __attribute__((address_space(3))) float* CK_lds = (__attribute__((address_space(3))) float*)(lds + OFF_CK);
#pragma unroll
    for (int d0 = 0; d0 < 8; ++d0) S.qr[d0] = load8(cur.Q + (size_t)(wid * QBLK + r32) * PQ + d0 * 16 + hi * 8);
    FOX_SLOAD(cur.K, cur.V, cur.NCK, cur.jlo * KVBLK, 0); FOX_VMW(); FOX_SWRITE_K(0);
    __syncthreads();
}
template <int PO>
__device__ __forceinline__ void fox_block(const BlockRef& cur, const Ctx& c, lchar* lds, Seam& S, unsigned& nidx) {
    const int tid = tid_local(), wid = __builtin_amdgcn_readfirstlane(tid >> 6), lane = tid & 63, r32 = lane & 31, hi = lane >> 5;
    constexpr unsigned W = 1u << 30;
    const int j_lo = cur.jlo, NT = (cur.P0 + QB - 1) / KVBLK + 1 - j_lo;
    const int qlo = cur.P0 + wid * QBLK, qm = qlo + r32 - 4 * hi;
    lchar* V_lds = lds; lchar* K_lds = lds + 2 * SHM_V;
    __attribute__((address_space(3))) float* ws = (__attribute__((address_space(3))) float*)(lds + OFF_WS) + wid * 64; __attribute__((address_space(3))) float* li_l = ws; __attribute__((address_space(3))) float* al_l = ws + 32;
    __attribute__((address_space(3))) float* CK_lds = (__attribute__((address_space(3))) float*)(lds + OFF_CK);
    float m_reg = -1e30f, l_reg = 0; f32x16 o[4] = {};
    const int sr = tid >> 4, sc = (tid & 15) * 8, vst0 = v_st(sr, sc), vst1 = v_st(32 + sr, sc), kws = FOX_KSWZ(sr, sc * 2);
    const int vb0 = (int)(unsigned)(uintptr_t)V_lds + v_rd_base(lane);
    const bf16* Kh = cur.K; const bf16* Vh = cur.V; const float* Ch = cur.NCK;
#define FOX_RESC(a) do { if (__any((a) < 1.f)) { if (hi == 0) al_l[r32] = (a); asm volatile("s_waitcnt lgkmcnt(0)" ::: "memory");              \
                     _Pragma("unroll") for (int d_ = 0; d_ < 4; ++d_) _Pragma("unroll") for (int r = 0; r < 16; ++r) o[d_][r] *= al_l[crow(r, hi)]; } } while (0)
#define FOX_KBASE(t) ((j_lo + (t)) * KVBLK)
#define FOX_MASKT(P0_, P1_, t, KB) do { const int kb_ = FOX_KBASE(t); bias_tile(P0_, P1_, (const lchar*)(CK_lds + (KB) * 64), hi); if (kb_ + KVBLK - 1 > qlo) mask_tile(P0_, P1_, qm - kb_, W); } while (0)
    constexpr int NQL = 8;
#define FOX_SEAM_K0() do { FOX_VMWN(NQL); FOX_SWRITE_K(0); FOX_SBAR(); } while (0)
    f32x16 pA0, pA1, pB0, pB1; float mnA, mnB, alA, alB; bf16x8 pa0, pa1, pa2, pa3;
    lchar* qs = lds + OFF_Q + wid * 8192 + lane * 16;
    FOX_VMW();
    unsigned nraw = 0u; if (tid == 0) nraw = __hip_atomic_fetch_add(c.qc, 1u, __ATOMIC_RELAXED, __HIP_MEMORY_SCOPE_AGENT);
#pragma unroll
    for (int d0 = 0; d0 < 8; ++d0) *reinterpret_cast<__attribute__((address_space(3))) bf16x8*>(qs + d0 * 1024) = S.qr[d0];
    FOX_SWRITE_V(0); FOX_SBAR();
    if (NT > 1) { FOX_SLOAD(Kh, Vh, Ch, FOX_KBASE(1), 1); }
    FOX_SBAR(); qkt<0>(pA0, pA1, K_lds, r32, hi, qs);
    FOX_MASKT(pA0, pA1, 0, 0); partialSM(pA0, pA1, m_reg, mnA, alA);
    if (NT > 1) { FOX_VMW(); FOX_SWRITE(1); }
    if (tid == 0) *c.slot = nraw;
    __syncthreads();
#define FOX_HALF_STEP(PX0, PX1, mnX, alX, PY0, PY1, alY, t, KB, VB, SB) do {                                                      \
        FOX_SBAR(); qkt<KB>(PX0, PX1, K_lds, r32, hi, qs);                                             \
        finishSM(PY0, PY1, alY, l_reg, pa0, pa1, pa2, pa3); FOX_SBAR();                                                           \
        if ((t) + 1 < NT) { FOX_SLOAD(Kh, Vh, Ch, FOX_KBASE((t) + 1), SB); FOX_SBAR(); }                                               \
        pv_tile<VB>(o, vb0, pa0, pa1, pa2, pa3); FOX_MASKT(PX0, PX1, (t), KB); partialSM(PX0, PX1, m_reg, mnX, alX);                                        \
        __syncthreads();                                                                                                      \
        if ((t) + 1 < NT) { FOX_VMW(); FOX_SWRITE(SB); }                                                                          \
        FOX_RESC(alX); __syncthreads(); } while (0)
    for (int t = 1; t + 1 < NT; t += 2) {
        FOX_HALF_STEP(pB0, pB1, mnB, alB, pA0, pA1, alA, t, 1, 0, 0);
        FOX_HALF_STEP(pA0, pA1, mnA, alA, pB0, pB1, alB, t + 1, 0, 1, 1);
    }
    const bool even = (NT & 1) == 0;
    if (even) { FOX_SBAR(); qkt<1>(pB0, pB1, K_lds, r32, hi, qs); FOX_SBAR(); }
    nidx = (unsigned)__builtin_amdgcn_readfirstlane((int)*c.slot);
    const BlockRef nxt = nidx < c.end ? item_ref(c, nidx) : cur;
    FOX_SLOAD(nxt.K, nxt.V, nxt.NCK, nxt.jlo * KVBLK, 0); FOX_SBAR();
#pragma unroll
    for (int d0 = 0; d0 < 8; ++d0) S.qr[d0] = load8(nxt.Q + (size_t)(wid * QBLK + r32) * PQ + d0 * 16 + hi * 8);
    FOX_SBAR();
    finishSM(pA0, pA1, alA, l_reg, pa0, pa1, pa2, pa3); FOX_SBAR();
    pv_tile<0>(o, vb0, pa0, pa1, pa2, pa3);
    if (even) { FOX_MASKT(pB0, pB1, NT - 1, 1); partialSM(pB0, pB1, m_reg, mnB, alB); __syncthreads(); FOX_RESC(alB);
        finishSM(pB0, pB1, alB, l_reg, pa0, pa1, pa2, pa3); FOX_SBAR(); pv_tile<1>(o, vb0, pa0, pa1, pa2, pa3); }
    FOX_SBAR(); FOX_SEAM_K0();
    if (hi == 0) li_l[r32] = l_reg; asm volatile("s_waitcnt lgkmcnt(0)" ::: "memory");
    float rli[16];
#pragma unroll
    for (int r = 0; r < 16; ++r) rli[r] = __builtin_amdgcn_rcpf(li_l[crow(r, hi)]);
    bf16* Ow = cur.O + (size_t)(wid * QBLK) * PO;
#pragma unroll
    for (int r = 0; r < 16; ++r) { const int orow = crow(r, hi);
#pragma unroll
        for (int d0 = 0; d0 < 4; ++d0) { const float v = o[d0][r] * rli[r];
            const float vn = __shfl_xor(v, 1);
            if ((r32 & 1) == 0) *(unsigned*)(Ow + (size_t)orow * PO + d0 * 32 + r32) = cvtpk(v, vn); } }
    __syncthreads();
#undef FOX_RESC
#undef FOX_KBASE
#undef FOX_MASKT
#undef FOX_SEAM_K0
#undef FOX_HALF_STEP
}
#undef FOX_ROW
#undef FOX_VMW
#undef FOX_VMWN
#undef FOX_SLOAD
#undef FOX_SWRITE_K
#undef FOX_SWRITE_V
#undef FOX_SWRITE
}
#define GAS __attribute__((address_space(1)))
#define LAS __attribute__((address_space(3)))
typedef unsigned short bf16;
typedef unsigned v4u __attribute__((ext_vector_type(4)));
typedef float f32x4 __attribute__((ext_vector_type(4)));
typedef short bf16x8 __attribute__((ext_vector_type(8)));
typedef GAS unsigned gu32;
typedef GAS unsigned long long gu64;
#define RLX_AGENT __ATOMIC_RELAXED, __HIP_MEMORY_SCOPE_AGENT
#define LDS_WAIT() asm volatile("s_waitcnt lgkmcnt(0)" ::: "memory")
#define VM_WAIT() asm volatile("s_waitcnt vmcnt(0)" ::: "memory")
__device__ __forceinline__ unsigned long long rt() { return __builtin_amdgcn_s_memrealtime(); }
__device__ __forceinline__ unsigned f2bf(float f) { unsigned u = __builtin_bit_cast(unsigned, f); return (u + 0x7fffu + ((u >> 16) & 1u)) >> 16; }
__device__ __forceinline__ unsigned pk2(float lo, float hi) { return f2bf(lo) | (f2bf(hi) << 16); }

#define XB_TMO      128
#define XB_XCNT(j)  (256  + 64 * (j))
#define XB_XSUB(j)  (1280 + 64 * (j))
#define XB_XGEN(j)  (2304 + 64 * (j))
#define XB_TOP      3328
#define XB_TOPGEN   3392
#define XCD_BAR_WORDS 3456
#define XB_SPIN_CAP (1u << 18)

__device__ __forceinline__ unsigned xb_ld(unsigned* p)              { return __hip_atomic_load(p, __ATOMIC_RELAXED, __HIP_MEMORY_SCOPE_AGENT); }
__device__ __forceinline__ unsigned xb_add(unsigned* p, unsigned v) { return __hip_atomic_fetch_add(p, v, __ATOMIC_RELAXED, __HIP_MEMORY_SCOPE_AGENT); }
__device__ __forceinline__ unsigned xb_xcc_id() { return (unsigned)__builtin_amdgcn_s_getreg((3 << 11) | 20) & 0xFu; }
#define XB_SPIN(cond, bar) do { unsigned _sp = 0; while (cond) { __builtin_amdgcn_s_sleep(1); \
    if ((++_sp & 255u) == 0u) { if (xb_ld(&(bar)[XB_TMO])) break; if (_sp > XB_SPIN_CAP) { atomicAdd(&(bar)[XB_TMO], 1u); break; } } } } while (0)

struct XcdBarrier {
    unsigned* bar; unsigned x;
    volatile LAS unsigned* st;
};

__device__ __forceinline__ XcdBarrier xcd_barrier_post(unsigned* bar, volatile LAS unsigned* st) {
    XcdBarrier b; b.bar = bar; b.x = xb_xcc_id(); b.st = st;
    if (threadIdx.x == 0) (void)xb_add(&bar[XB_XCNT(b.x)], 1u);
    return b;
}
__device__ __forceinline__ void xcd_barrier_complete(unsigned* bar, unsigned x, unsigned& nloc, unsigned& nx) {
    const unsigned G = gridDim.x * gridDim.y * gridDim.z;
    unsigned sum, cnt, mine, sp = 0u;
    for (;;) {
        sum = 0u; cnt = 0u; mine = 0u;
#pragma unroll
        for (unsigned j = 0; j < 16; ++j) { const unsigned c = xb_ld(&bar[XB_XCNT(j)]); sum += c; cnt += (c > 0u) ? 1u : 0u; mine = (j == x) ? c : mine; }
        if (sum == G) break;
        __builtin_amdgcn_s_sleep(1);
        if ((++sp & 255u) == 0u) { if (xb_ld(&bar[XB_TMO])) break; if (sp > XB_SPIN_CAP) { atomicAdd(&bar[XB_TMO], 1u); break; } }
    }
    nloc = mine > 0u ? mine : 1u; nx = cnt > 0u ? cnt : 1u;
}

__device__ __forceinline__ void xcd_barrier(const XcdBarrier& b) {
    asm volatile("s_waitcnt vmcnt(0)" ::: "memory");
    __syncthreads();
    if (threadIdx.x == 0) {
        unsigned* bar = b.bar;
        __builtin_amdgcn_s_waitcnt(0);
        unsigned nloc = b.st[0], nx = b.st[1];
        if (nloc == 0u) { xcd_barrier_complete(bar, b.x, nloc, nx); b.st[0] = nloc; b.st[1] = nx; }
        const unsigned old = xb_add(&bar[XB_XSUB(b.x)], 1u);
        const unsigned gen = old / nloc;
        if (old + 1u == (gen + 1u) * nloc) {
            __builtin_amdgcn_fence(__ATOMIC_RELEASE, "agent");
            asm volatile("s_waitcnt vmcnt(0)" ::: "memory");
            const unsigned og = xb_add(&bar[XB_TOP], 1u);
            const unsigned tg = og / nx;
            if (og + 1u == (tg + 1u) * nx) xb_add(&bar[XB_TOPGEN], 1u);
            else XB_SPIN(xb_ld(&bar[XB_TOPGEN]) == tg, bar);
            __builtin_amdgcn_fence(__ATOMIC_ACQUIRE, "agent");
            xb_add(&bar[XB_XGEN(b.x)], 1u);
            asm volatile("s_waitcnt vmcnt(0)" ::: "memory");
        } else {
            XB_SPIN(xb_ld(&bar[XB_XGEN(b.x)]) == gen, bar);
            __builtin_amdgcn_fence(__ATOMIC_ACQUIRE, "agent");
            asm volatile("s_waitcnt vmcnt(0)" ::: "memory");
        }
    }
    __syncthreads();
}

typedef unsigned u32x2 __attribute__((ext_vector_type(2)));
typedef float f32x2 __attribute__((ext_vector_type(2)));
typedef LAS unsigned char* lptr;
struct Frame {
    lptr lds; int tid, lane, wave, G, bx, z;
    unsigned char* ws; const float* const __attribute__((address_space(4)))* ka;
};
#define WSP(type, off) ((type*)(F.ws + (size_t)(off) + (size_t)(unsigned)F.z))
#define INP(k) ((const float*)F.ka[(k) + F.z])
#define PHASE_LOCAL() do { asm volatile("s_mov_b32 %0, 0" : "=s"(F.z)); F.tid = tid_local(); F.lane = F.tid & 63; F.wave = __builtin_amdgcn_readfirstlane(F.tid >> 6); } while (0)
__device__ __forceinline__ float bf2f(unsigned b) { return __builtin_bit_cast(float, b << 16); }
__device__ __forceinline__ float wave_sum(float v) {
#pragma unroll
    for (int o = 1; o < 64; o <<= 1) v += __shfl_xor(v, o);
    return v;
}
__device__ __forceinline__ void unpack8(const v4u w, float (&f)[8]) {
    f[0] = bf2f(w.x & 0xffffu); f[1] = __builtin_bit_cast(float, w.x & 0xffff0000u); f[2] = bf2f(w.y & 0xffffu); f[3] = __builtin_bit_cast(float, w.y & 0xffff0000u);
    f[4] = bf2f(w.z & 0xffffu); f[5] = __builtin_bit_cast(float, w.z & 0xffff0000u); f[6] = bf2f(w.w & 0xffffu); f[7] = __builtin_bit_cast(float, w.w & 0xffff0000u);
}
__device__ __forceinline__ v4u pack8(const float (&f)[8]) { v4u w; w.x = pk2(f[0], f[1]); w.y = pk2(f[2], f[3]); w.z = pk2(f[4], f[5]); w.w = pk2(f[6], f[7]); return w; }
__device__ __forceinline__ float silu_f(float x) { return x * __builtin_amdgcn_rcpf(1.f + __expf(-x)); }
__device__ __forceinline__ float softplus_f(float x) { return fmaxf(x, 0.f) + log1pf(__expf(-fabsf(x))); }
#define WG_BAR() __syncthreads()
#define LDS_BAR() asm volatile("s_waitcnt lgkmcnt(0)\n\ts_barrier" ::: "memory")

__device__ __forceinline__ int kperm(int k) { return (k & ~31) | ((k & 12) << 1) | ((k & 16) >> 2) | (k & 3); }

__device__ __forceinline__ void transpose_item(const float* W, int K, int Ns, bf16* WT, int kb, int nb, int srcc, int lane, const float* gain = nullptr) {
    const int kc = lane & 7, ng = lane >> 3, k0 = 64 * kb + 8 * kc, n0 = 32 * nb + 4 * ng;
    f32x4 v[8];
#pragma unroll
    for (int i = 0; i < 8; ++i) v[i] = srcc >= 0 ? *(const f32x4*)(W + (size_t)(k0 + i) * Ns + srcc) : (f32x4){0.f, 0.f, 0.f, 0.f};
    if (gain) { const f32x4 g0 = *(const f32x4*)(gain + k0), g1 = *(const f32x4*)(gain + k0 + 4);
#pragma unroll
        for (int i = 0; i < 4; ++i) { v[i] = v[i] * g0[i]; v[4 + i] = v[4 + i] * g1[i]; } }
#pragma unroll
    for (int j = 0; j < 4; ++j) { v4u o; o.x = pg8::cvt_pk_bf16(v[0][j], v[1][j]); o.y = pg8::cvt_pk_bf16(v[2][j], v[3][j]); o.z = pg8::cvt_pk_bf16(v[4][j], v[5][j]); o.w = pg8::cvt_pk_bf16(v[6][j], v[7][j]);
        *(v4u*)(WT + (size_t)(n0 + j) * K + k0) = o; }
}
__device__ __forceinline__ int map_win(int d) { return d < 5632 ? d : (d < 11776 ? d + 12 : (d < 11788 ? d - 6144 : (d < IN_DIM ? d : -1))); }
__device__ __forceinline__ int map_wup(int d) { const int p = d >> 8, j = d & 255; return j < 128 ? 128 * p + j : FFN + 128 * p + (j - 128); }
constexpr int CV_NB_IN = NPROJ / 32, CV_NB_O = DM / 32, CV_NB_UP = FFN2 / 32, CV_NB_DN = DM / 32;
constexpr int CV_I_IN = (DM / 64) * CV_NB_IN, CV_I_PW = 4 * 4 * 8, CV_I_O = (DM / 64) * CV_NB_O, CV_I_UP = (DM / 64) * CV_NB_UP, CV_I_DN = (FFN / 64) * CV_NB_DN;
constexpr int CV_NPER = CV_I_IN + CV_I_PW + CV_I_O + CV_I_UP + CV_I_DN;
constexpr int CV_W_IN = CV_I_IN + CV_I_PW, CV_W_O = CV_W_IN + CV_I_O, CV_W_UP = CV_W_O + CV_I_UP;
struct CvPtrs { const float *w_in, *pool_w, *w_o, *w_up, *w_down, *g_mix, *g_ffn; bf16 *WinT, *PWT, *WoT, *WupT, *WdnT; };
__device__ __forceinline__ void convert_item(const CvPtrs& P, int l, int r, int lane) {
    if (r < CV_I_IN) { const int kb = r / CV_NB_IN, nb = r % CV_NB_IN; transpose_item(P.w_in + (size_t)l * DM * IN_DIM, DM, IN_DIM, P.WinT + (size_t)l * NPROJ * DM, kb, nb, map_win(32 * nb + 4 * (lane >> 3)), lane, P.g_mix + l * DM); return; } r -= CV_I_IN;
    if (r < CV_I_PW) { const int g = r >> 5, kb = (r >> 3) & 3, nb = r & 7; transpose_item(P.pool_w + (size_t)(l * 4 + g) * 65536, 256, 256, P.PWT + (size_t)(l * 4 + g) * 65536, kb, nb, 32 * nb + 4 * (lane >> 3), lane); return; } r -= CV_I_PW;
    if (r < CV_I_O) { const int kb = r / CV_NB_O, nb = r % CV_NB_O; transpose_item(P.w_o + (size_t)l * DM * DM, DM, DM, P.WoT + (size_t)l * DM * DM, kb, nb, 32 * nb + 4 * (lane >> 3), lane); return; } r -= CV_I_O;
    if (r < CV_I_UP) { const int kb = r / CV_NB_UP, nb = r % CV_NB_UP; transpose_item(P.w_up + (size_t)l * DM * FFN2, DM, FFN2, P.WupT + (size_t)l * FFN2 * DM, kb, nb, map_wup(32 * nb + 4 * (lane >> 3)), lane, P.g_ffn + l * DM); return; } r -= CV_I_UP;
    { const int kb = r / CV_NB_DN, nb = r % CV_NB_DN; transpose_item(P.w_down + (size_t)l * FFN * DM, FFN, DM, P.WdnT + (size_t)l * DM * FFN, kb, nb, 32 * nb + 4 * (lane >> 3), lane); }
}
#define CV_PTRS() CvPtrs P; P.w_in = INP(2); P.pool_w = INP(3); P.w_o = INP(10); P.w_up = INP(12); P.w_down = INP(14); P.g_mix = INP(1); P.g_ffn = INP(11); \
    P.WinT = WSP(bf16, WS_WIN); P.PWT = WSP(bf16, WS_PW); P.WoT = WSP(bf16, WS_WO); P.WupT = WSP(bf16, WS_WUP); P.WdnT = WSP(bf16, WS_WDN)
__device__ __forceinline__ void p0_prologue(Frame& F) {
    CV_PTRS();
    const int gw = F.bx * NWAVES + F.wave, NGW = F.G * NWAVES, lane = F.lane;
    for (int it = gw; it < CV_NPER; it += NGW) convert_item(P, 0, it, lane);
}
__device__ __forceinline__ void bg_convert(Frame& F, int quota_chunks, int watermark) {
    CV_PTRS();
    unsigned* qc = (unsigned*)(F.ws + WS_CTL) + CW_BG; const int lane = F.lane, w = F.wave;
    LAS unsigned* slot = (LAS unsigned*)(F.lds + MISC_OFF + 96);
    for (int done = 0; done < quota_chunks; ++done) {
        if (F.tid == 0) { unsigned v = 0xffffffffu; if ((int)__hip_atomic_load(qc, __ATOMIC_RELAXED, __HIP_MEMORY_SCOPE_AGENT) < watermark) v = __hip_atomic_fetch_add(qc, 64u, __ATOMIC_RELAXED, __HIP_MEMORY_SCOPE_AGENT); *slot = v; }
        __syncthreads(); const unsigned base = (unsigned)__builtin_amdgcn_readfirstlane((int)*slot); __syncthreads();
        if (base >= (unsigned)CV_NPER) break;
#pragma unroll 1
        for (int k = 0; k < 8; ++k) { const unsigned idx = base + 8u * k + (unsigned)w; if (idx < (unsigned)CV_NPER) convert_item(P, 1, (int)idx, lane); }
    }
}

__device__ __forceinline__ void rms_rows_bf16(Frame& F, const float* X, const float* gain, bf16* O) {
    const int gw = F.bx * NWAVES + F.wave, NGW = F.G * NWAVES;
    for (int m = gw; m < M; m += NGW) {
        const f32x4* xr = (const f32x4*)(X + (size_t)m * DM) + F.lane; const f32x4* gr = (const f32x4*)gain + F.lane;
        f32x4 v[16]; float s = 0.f;
#pragma unroll
        for (int j = 0; j < 16; ++j) { v[j] = xr[64 * j]; s += (v[j].x * v[j].x + v[j].y * v[j].y) + (v[j].z * v[j].z + v[j].w * v[j].w); }
        const float r = rsqrtf(wave_sum(s) * (1.f / DM) + EPS);
        unsigned long long* o8 = (unsigned long long*)(O + (size_t)m * DM) + F.lane;
#pragma unroll
        for (int j = 0; j < 16; ++j) { const f32x4 g = gr[64 * j]; o8[64 * j] = (unsigned long long)pk2(v[j].x * r * g.x, v[j].y * r * g.y) | ((unsigned long long)pk2(v[j].z * r * g.z, v[j].w * r * g.w) << 32); }
    }
}
__device__ __forceinline__ void cast_rows_stat(Frame& F, const float* X, bf16* O, float* rss) {
    const int gw = F.bx * NWAVES + F.wave, NGW = F.G * NWAVES;
    for (int m = gw; m < M; m += NGW) {
        const f32x4* xr = (const f32x4*)(X + (size_t)m * DM) + F.lane;
        f32x4 v[16]; float s = 0.f;
#pragma unroll
        for (int j = 0; j < 16; ++j) { v[j] = xr[64 * j]; }
        unsigned long long* o8 = (unsigned long long*)(O + (size_t)m * DM) + F.lane;
#pragma unroll
        for (int j = 0; j < 16; ++j) { s += (v[j].x * v[j].x + v[j].y * v[j].y) + (v[j].z * v[j].z + v[j].w * v[j].w); o8[64 * j] = (unsigned long long)pk2(v[j].x, v[j].y) | ((unsigned long long)pk2(v[j].z, v[j].w) << 32); }
        s = wave_sum(s);
        if (F.lane == 0) rss[m] = s;
    }
}
__device__ __forceinline__ void rms_rows_f32(Frame& F, const float* X, const float* gain, float* O) {
    const int gw = F.bx * NWAVES + F.wave, NGW = F.G * NWAVES;
    for (int m = gw; m < M; m += NGW) {
        const f32x4* xr = (const f32x4*)(X + (size_t)m * DM) + F.lane; const f32x4* gr = (const f32x4*)gain + F.lane;
        f32x4 v[16]; float s = 0.f;
#pragma unroll
        for (int j = 0; j < 16; ++j) { v[j] = xr[64 * j]; s += (v[j].x * v[j].x + v[j].y * v[j].y) + (v[j].z * v[j].z + v[j].w * v[j].w); }
        const float r = rsqrtf(wave_sum(s) * (1.f / DM) + EPS);
        f32x4* o = (f32x4*)(O + (size_t)m * DM) + F.lane;
#pragma unroll
        for (int j = 0; j < 16; ++j) { const f32x4 g = gr[64 * j]; o[64 * j] = v[j] * r * g; }
    }
}

template <int WIN>
__device__ __forceinline__ void pool_stage1(const bf16* src, int tseq0, int t0, LAS bf16* Prow  ) {
    constexpr int NR = WIN + 3; v4u r[NR];
#pragma unroll
    for (int i = 0; i < NR; ++i) { const int j = t0 - (WIN - 1) + i; r[i] = (tseq0 + j >= 0) ? *(const v4u*)(src + (ptrdiff_t)j * PQ) : (v4u){0u, 0u, 0u, 0u}; }
    float s[8];
#pragma unroll
    for (int e = 0; e < 8; ++e) s[e] = 0.f;
#pragma unroll
    for (int i = 0; i < WIN - 1; ++i) { float v[8]; unpack8(r[i], v);
#pragma unroll
        for (int e = 0; e < 8; ++e) s[e] += v[e]; }
#pragma unroll
    for (int i = 0; i < 4; ++i) { const int t = t0 + i; float cur[8]; unpack8(r[WIN - 1 + i], cur);
#pragma unroll
        for (int e = 0; e < 8; ++e) s[e] += cur[e];
        const int pos = tseq0 + t + 1; const float inv = 1.f / (float)(pos < WIN ? pos : WIN); float o[8];
#pragma unroll
        for (int e = 0; e < 8; ++e) o[e] = s[e] * inv - cur[e];
        *(LAS v4u*)(Prow + t * 264) = pack8(o);
        float old[8]; unpack8(r[i], old);
#pragma unroll
        for (int e = 0; e < 8; ++e) s[e] -= old[e]; }
}
__device__ __forceinline__ void pool_unit(Frame& F, int layer, const int u) {
    bf16* const PWT = WSP(bf16, WS_PW); bf16* const PROJ = WSP(bf16, WS_PROJ); bf16* const MIX = WSP(bf16, WS_MIX); const float* const pool_scale = INP(4);
    LAS bf16* P = (LAS bf16*)F.lds;
    constexpr int PST = 264;
    const bf16* PW = PWT + (size_t)layer * 4 * 65536; const float* scale = pool_scale + layer * POOL_DIM;
    const int tid = F.tid, lane = F.lane, w = F.wave, r16 = lane & 15, q4 = lane >> 4;
    {
        const int tile = u >> 2, g = u & 3, m0 = tile * 64, tseq0 = m0 & (SEQ - 1);
        {
            const int c8 = tid & 31, t0 = 4 * (tid >> 5);
            const bf16* src = PROJ + (size_t)m0 * PQ + C_POOL + g * 256 + c8 * 8;
            if (g == 0) pool_stage1<2>(src, tseq0, t0, P + c8 * 8); else if (g == 1) pool_stage1<4>(src, tseq0, t0, P + c8 * 8);
            else if (g == 2) pool_stage1<8>(src, tseq0, t0, P + c8 * 8); else pool_stage1<16>(src, tseq0, t0, P + c8 * 8);
        }
        bf16x8 wf[8][2];
#pragma unroll
        for (int ks = 0; ks < 8; ++ks)
#pragma unroll
            for (int ne = 0; ne < 2; ++ne) wf[ks][ne] = *(const bf16x8*)(PW + (size_t)(g * 256 + 32 * w + 16 * ne + r16) * 256 + 32 * ks + 8 * q4);
        LDS_BAR();
        {
            f32x4 acc[2][4];
#pragma unroll
            for (int a = 0; a < 2; ++a)
#pragma unroll
                for (int bq = 0; bq < 4; ++bq) acc[a][bq] = (f32x4){0.f, 0.f, 0.f, 0.f};
#pragma unroll
            for (int ks = 0; ks < 8; ++ks) {
                bf16x8 pf[4];
#pragma unroll
                for (int tt = 0; tt < 4; ++tt) pf[tt] = *(const LAS bf16x8*)(P + (16 * tt + r16) * PST + 32 * ks + 8 * q4);
#pragma unroll
                for (int ne = 0; ne < 2; ++ne)
#pragma unroll
                    for (int tt = 0; tt < 4; ++tt) acc[ne][tt] = __builtin_amdgcn_mfma_f32_16x16x32_bf16(wf[ks][ne], pf[tt], acc[ne][tt], 0, 0, 0);
            }
#pragma unroll
            for (int ne = 0; ne < 2; ++ne) { const int e = 32 * w + 16 * ne + 4 * q4; const f32x4 sc = *(const f32x4*)(scale + g * 256 + e);
#pragma unroll
                for (int tt = 0; tt < 4; ++tt) { const int t = 16 * tt + r16; const f32x4 v = acc[ne][tt] * sc;
                    u32x2 o; o.x = pk2(v.x, v.y); o.y = pk2(v.z, v.w);
                    *(u32x2*)(MIX + (size_t)(m0 + t) * DM + g * 256 + e) = o; } }
        }
        LDS_BAR();
    }
}

__device__ __forceinline__ void fox_cum_phase(Frame& F, int layer) {
    float* const SMALL = WSP(float, WS_SMALL); float* const NCK = WSP(float, WS_NCK); const float* const fox_bias = INP(5); const float* const BND = (const float*)(F.ws + WS_CTL) + CW_BND + layer * (BATCH * 24 * 4); int* const JLO = WSP(int, WS_JLO);
    LAS float* WT = (LAS float*)F.lds;
    LAS float* TE = WT + 32; LAS float* BS = WT + 96;
    const int lane = F.lane, w = F.wave;
    for (int bh = F.bx; bh < BATCH * NH; bh += F.G) {
        const int b = bh / NH, h = bh % NH; const float fb = fox_bias[layer * NH + h];
        const int t0 = 512 * w + 8 * lane;
        const float* src = SMALL + (size_t)(b * SEQ + t0) * 64 + SM_FF + h;
        float lf[8];
#pragma unroll
        for (int i = 0; i < 8; ++i) lf[i] = src[(size_t)i * 64];
        float s = 0.f;
#pragma unroll
        for (int i = 0; i < 8; ++i) { const float xx = lf[i] + fb; s += fminf(xx, 0.f) - log1pf(__expf(-fabsf(xx))); lf[i] = s; }
        float inc = s;
#pragma unroll
        for (int off = 1; off < 64; off <<= 1) { const float v = __shfl_up(inc, off); if (lane >= off) inc += v; }
        if (lane == 63) WT[w] = inc;
        LDS_BAR();
        float base = inc - s;
        for (int k = 0; k < w; ++k) base += WT[k];
        float nck[8];
#pragma unroll
        for (int i = 0; i < 8; ++i) nck[i] = -(base + lf[i]) * 11.313708498984761f;
        float* dst = NCK + (size_t)bh * SEQ + t0;
        *(f32x4*)dst = (f32x4){nck[0], nck[1], nck[2], nck[3]}; *(f32x4*)(dst + 4) = (f32x4){nck[4], nck[5], nck[6], nck[7]};
        if ((t0 & 63) == 56) TE[t0 >> 6] = nck[7];
        if ((t0 & 255) == 0) BS[t0 >> 8] = nck[0];
        LDS_BAR();
        if (F.tid < SEQ / 256) {
            const f32x4 bq = *(const f32x4*)(BND + (b * 24 + h) * 4), bk = *(const f32x4*)(BND + (b * 24 + 12 + h) * 4);
            const float qm = (bq[0] + bq[1]) + (bq[2] + bq[3]), km = (bk[0] + bk[1]) + (bk[2] + bk[3]);
            const float bound = 2.04f * sqrtf(qm * km) + 115.f * 11.313708498984761f;
            const int qb = F.tid; const float bs = BS[qb]; int jl = 0;
            for (int j = 0; j < 4 * qb; ++j) jl += (bs - TE[j] > bound) ? 1 : 0;
            JLO[bh * (SEQ / 256) + qb] = jl;
        }
        LDS_BAR();
    }
}

constexpr int GP_RT = 0, GP_RT_SZ = 64 * 264 * 2, GP_AL = GP_RT + 2 * GP_RT_SZ, GP_AL_SZ = 64 * 64 * 4, GP_GT = GP_AL + 2 * GP_AL_SZ, GP_GT_SZ = 1024, GP_KB = GP_GT + 2 * GP_GT_SZ, GP_QB = GP_KB + 64 * 136 * 2, GP_DL = GP_QB + 64 * 136 * 2, GP_END = GP_DL + 4 * 16 * 16 * 4;
static_assert(GP_END <= RING_BYTES, "gdn prep LDS");
__device__ __forceinline__ void gdn_prep_phase(Frame& F, int layer) {
    bf16* const PROJ = WSP(bf16, WS_PROJ); bf16* const NEGW = WSP(bf16, WS_NEGW); bf16* const QDEC = WSP(bf16, WS_QDEC); bf16* const KDT = WSP(bf16, WS_KDT); bf16* const INTRA = WSP(bf16, WS_INTRA);
    float* const SMALL = WSP(float, WS_SMALL); float* const UT = WSP(float, WS_UT); float* const EGL = WSP(float, WS_EGL);
    const float* const gconv_w = INP(6); const float* const g_Alog = INP(7); const float* const g_dtb = INP(8);
    LAS bf16* KB = (LAS bf16*)(F.lds + GP_KB);
    LAS bf16* QB = (LAS bf16*)(F.lds + GP_QB);
    const int tid = F.tid, lane = F.lane, w = F.wave;
    const float* convw = gconv_w + (size_t)layer * 4 * (3 * GDN_DIM);
#ifndef PREP_REP
#define PREP_REP 1
#endif
    const int nun1 = (NUNIT_GDN - F.bx + F.G - 1) / F.G, nun = nun1 * PREP_REP;
    if (nun <= 0) return;
    if (w < 4) {
        const int cg = tid & 15, tq = tid >> 4, tb = 4 * tq;
        v4u rows[3][7];
#define GP_FETCH(u_) do { const int bh_ = (u_) >> 6, n_ = (u_) & 63, b_ = bh_ / NH, h_ = bh_ % NH, m0_ = b_ * SEQ + n_ * 64; const bool ok_ = (n_ * 64 + tb) > 0;     \
        const bf16* p0_ = PROJ + (size_t)(m0_ + tb) * PQ + (C_GQ + h_ * HD + cg * 8); \
        _Pragma("unroll") for (int wh = 0; wh < 3; ++wh) _Pragma("unroll") for (int i = 0; i < 7; ++i) { const v4u r_ = *(const v4u*)(p0_ + wh * GDN_DIM + (ptrdiff_t)((i < 3 && !ok_) ? 0 : i - 3) * PQ); rows[wh][i] = (i < 3 && !ok_) ? (v4u){0u, 0u, 0u, 0u} : r_; } } while (0)
        GP_FETCH(F.bx);
#pragma unroll 1
        for (int i = 0; i < nun; ++i) {
            const int u = F.bx + (i % nun1) * F.G, bh = u >> 6, h = bh % NH, sel = i & 1;
            LAS bf16* RT = (LAS bf16*)(F.lds + GP_RT + sel * GP_RT_SZ);
            LAS float* AL = (LAS float*)(F.lds + GP_AL + sel * GP_AL_SZ);
            const LAS float* GT = (const LAS float*)(F.lds + GP_GT + sel * GP_GT_SZ);
#ifndef PB_CONV
#define PB_CONV 1
#endif
#ifndef PB_B
#define PB_B 1
#endif
#ifndef PB_SOLVE
#define PB_SOLVE 1
#endif
            for (int pbc_ = 0; pbc_ < PB_CONV; ++pbc_)
#pragma unroll
            for (int wh = 0; wh < 3; ++wh) {
                const int wcol = wh * GDN_DIM + h * HD + cg * 8;
                float cw[4][8];
#pragma unroll
                for (int tap = 0; tap < 4; ++tap) { const f32x4 w0 = *(const f32x4*)(convw + (size_t)tap * (3 * GDN_DIM) + wcol), w1 = *(const f32x4*)(convw + (size_t)tap * (3 * GDN_DIM) + wcol + 4);
                    cw[tap][0] = w0.x; cw[tap][1] = w0.y; cw[tap][2] = w0.z; cw[tap][3] = w0.w; cw[tap][4] = w1.x; cw[tap][5] = w1.y; cw[tap][6] = w1.z; cw[tap][7] = w1.w; }
                LAS bf16* const qkrow = (wh == 0 ? QB : KB) + tb * 136 + cg * 8; LAS bf16* const rtrow = RT + tb * 264 + (wh == 1 ? 128 : 0) + cg * 8;
                float win[4][8]; unpack8(rows[wh][0], win[0]); unpack8(rows[wh][1], win[1]); unpack8(rows[wh][2], win[2]);
#pragma unroll
                for (int j = 0; j < 4; ++j) { float acc[8];
                    unpack8(rows[wh][j + 3], win[(j + 3) & 3]);
#pragma unroll
                    for (int e = 0; e < 8; ++e) acc[e] = cw[0][e] * win[j & 3][e] + cw[1][e] * win[(j + 1) & 3][e] + cw[2][e] * win[(j + 2) & 3][e] + cw[3][e] * win[(j + 3) & 3][e];
                    float ss = 0.f;
#pragma unroll
                    for (int e = 0; e < 8; ++e) { acc[e] = silu_f(acc[e]); ss += acc[e] * acc[e]; }
                    if (wh < 2) { ss += __shfl_xor(ss, 1); ss += __shfl_xor(ss, 2); ss += __shfl_xor(ss, 4); ss += __shfl_xor(ss, 8);
                        const float rn = rsqrtf(ss + EPS) * (wh == 0 ? 0.08838834764831845f : 1.f);
#pragma unroll
                        for (int e = 0; e < 8; ++e) acc[e] *= rn; }
                    const v4u pk = pack8(acc);
                    if (wh < 2) *(LAS v4u*)(qkrow + j * 136) = pk;
                    if (wh > 0) *(LAS v4u*)(rtrow + j * 264) = pk;
                }
            }
            __builtin_amdgcn_sched_barrier(0);
            if (i + 1 < nun) GP_FETCH(F.bx + ((i + 1) % nun1) * F.G);
            LDS_BAR();
            for (int pbb_ = 0; pbb_ < PB_B; ++pbb_) {
                const int ti = w, r16 = lane & 15, q4 = lane >> 4, c = 16 * ti + r16; const float gc = GT[c], bc = GT[64 + c];
#pragma unroll
                for (int mat = 0; mat < 2; ++mat) {
                    const LAS bf16* Xb = mat ? QB : KB; bf16x8 xf[4];
#pragma unroll
                    for (int ks = 0; ks < 4; ++ks) xf[ks] = *(const LAS bf16x8*)(Xb + c * 136 + 32 * ks + 8 * q4);
                    unsigned ipk[4][2];
#pragma unroll
                    for (int tj = 0; tj < 4; ++tj) {
                        f32x4 acc = (f32x4){0.f, 0.f, 0.f, 0.f};
                        if (tj <= ti) {
#pragma unroll
                            for (int ks = 0; ks < 4; ++ks) { const bf16x8 kf = *(const LAS bf16x8*)(KB + (16 * tj + r16) * 136 + 32 * ks + 8 * q4);
                                acc = __builtin_amdgcn_mfma_f32_16x16x32_bf16(kf, xf[ks], acc, 0, 0, 0); }
                        }
                        const int s0 = 16 * tj + 4 * q4; f32x4 o;
#pragma unroll
                        for (int r = 0; r < 4; ++r) { const int s = s0 + r; const float dec = __expf(fminf(gc - GT[s], 0.f));
                            o[r] = mat ? (c >= s ? acc[r] * dec : 0.f) : (c > s ? bc * acc[r] * dec : 0.f); }
                        if (mat) { ipk[tj][0] = pk2(o[0], o[1]); ipk[tj][1] = pk2(o[2], o[3]); }
                        else *(LAS f32x4*)(AL + c * 64 + s0) = o;
                    }
                    if (mat) { bf16* ir = INTRA + (size_t)u * 4096 + c * 64 + 8 * q4;
                        *(v4u*)ir = (v4u){ipk[0][0], ipk[0][1], ipk[1][0], ipk[1][1]}; *(v4u*)(ir + 32) = (v4u){ipk[2][0], ipk[2][1], ipk[3][0], ipk[3][1]}; }
                }
            }
#pragma unroll
            for (int it = 0; it < 4; ++it) {
                const int id = it * 256 + tid, t = id >> 4, pp = id & 15, kq = 32 * (pp >> 2) + 4 * (pp & 3);
                const u32x2 lo = *(const LAS u32x2*)(QB + t * 136 + kq), hi = *(const LAS u32x2*)(QB + t * 136 + kq + 16); float v[8]; unpack8((v4u){lo.x, lo.y, hi.x, hi.y}, v); const float eg = GT[128 + t];
#pragma unroll
                for (int e = 0; e < 8; ++e) v[e] *= eg;
                *(v4u*)(QDEC + (size_t)u * 8192 + t * 128 + 8 * pp) = pack8(v); }
            LDS_BAR();
        }
        LDS_BAR(); LDS_BAR();
#undef GP_FETCH
    } else {
        const int j = tid - 256;
        float ga = 0.f, gb = 0.f;
#define GP_GFETCH(u_) do { if (w == 4) { const int bh_ = (u_) >> 6, n_ = (u_) & 63, b_ = bh_ / NH, h_ = bh_ % NH, m0_ = b_ * SEQ + n_ * 64; ga = SMALL[(size_t)(m0_ + lane) * 64 + SM_GA + h_]; gb = SMALL[(size_t)(m0_ + lane) * 64 + SM_GB + h_]; } } while (0)
        GP_GFETCH(F.bx);
#pragma unroll 1
        for (int i = -1; i < nun; ++i) {
            const bool has_next = i + 1 < nun; const int un = F.bx + ((i + 1) % nun1) * F.G, seln = (i + 1) & 1;
            if (has_next && w == 4) {
                LAS float* GTn = (LAS float*)(F.lds + GP_GT + seln * GP_GT_SZ); const int hn = (un >> 6) % NH;
                const float beta = 1.f / (1.f + __expf(-gb));
                float g = -__expf(g_Alog[layer * NH + hn]) * softplus_f(ga + g_dtb[layer * NH + hn]);
#pragma unroll
                for (int off = 1; off < 64; off <<= 1) { const float v = __shfl_up(g, off); if (lane >= off) g += v; }
                const float eg = __expf(g);
                GTn[lane] = g; GTn[64 + lane] = beta; GTn[128 + lane] = eg; GTn[192 + lane] = beta * eg;
                if (i + 2 < nun) GP_GFETCH(F.bx + ((i + 2) % nun1) * F.G);
            }
            if (i >= 0) {
                const int u = F.bx + (i % nun1) * F.G, sel = i & 1;
                const LAS bf16* RT = (const LAS bf16*)(F.lds + GP_RT + sel * GP_RT_SZ); const LAS float* AL = (const LAS float*)(F.lds + GP_AL + sel * GP_AL_SZ); const LAS float* GT = (const LAS float*)(F.lds + GP_GT + sel * GP_GT_SZ);
                const int sw = w - 4, r16 = lane & 15, q4 = lane >> 4;
                LAS float* DL = (LAS float*)(F.lds + GP_DL);
                {
                    const LAS float* Ab = AL + (16 * q4) * 64 + 16 * q4; float d[16];
#pragma unroll
                    for (int r = 0; r < 16; ++r) { float a = (r == r16) ? 1.f : 0.f;
#pragma unroll
                        for (int k4 = 0; k4 < (r + 3) / 4; ++k4) { const f32x4 av = *(const LAS f32x4*)(Ab + r * 64 + 4 * k4);
#pragma unroll
                            for (int e = 0; e < 4; ++e) if (4 * k4 + e < r) a -= av[e] * d[4 * k4 + e]; }
                        d[r] = a; DL[(q4 * 16 + r) * 16 + r16] = a; }
                }
                asm volatile("s_waitcnt lgkmcnt(0)" ::: "memory");
                const LAS float* sc = GT + (sw < 2 ? 64 : 192);
                f32x4 X[4][4];
#pragma unroll
                for (int bi = 0; bi < 4; ++bi) {
                    f32x4 Y[4];
#pragma unroll
                    for (int ct = 0; ct < 4; ++ct)
#pragma unroll
                        for (int r = 0; r < 4; ++r) { const int row = 16 * bi + 4 * q4 + r; Y[ct][r] = bf2f(RT[row * 264 + 64 * sw + 16 * ct + r16]) * sc[row]; }
#pragma unroll
                    for (int bj = 0; bj < bi; ++bj) { const f32x4 av = *(const LAS f32x4*)(AL + (16 * bi + r16) * 64 + 16 * bj + 4 * q4);
#pragma unroll
                        for (int r = 0; r < 4; ++r)
#pragma unroll
                            for (int ct = 0; ct < 4; ++ct) Y[ct] = __builtin_amdgcn_mfma_f32_16x16x4f32(-av[r], X[bj][ct][r], Y[ct], 0, 0, 0); }
                    const f32x4 dv = *(const LAS f32x4*)(DL + (bi * 16 + r16) * 16 + 4 * q4);
#pragma unroll
                    for (int ct = 0; ct < 4; ++ct) X[bi][ct] = (f32x4){0.f, 0.f, 0.f, 0.f};
#pragma unroll
                    for (int r = 0; r < 4; ++r)
#pragma unroll
                        for (int ct = 0; ct < 4; ++ct) X[bi][ct] = __builtin_amdgcn_mfma_f32_16x16x4f32(dv[r], Y[ct][r], X[bi][ct], 0, 0, 0);
                }
                LDS_BAR();
                if (sw < 2) { float* dst = UT + (size_t)u * 8192 + (4 * q4) * 128 + 64 * sw + r16;
#pragma unroll
                    for (int bi = 0; bi < 4; ++bi)
#pragma unroll
                        for (int r = 0; r < 4; ++r)
#pragma unroll
                            for (int ct = 0; ct < 4; ++ct) dst[(16 * bi + r) * 128 + 16 * ct] = X[bi][ct][r];
                } else {
#pragma unroll
                    for (int ct = 0; ct < 4; ++ct) { bf16* dst = NEGW + (size_t)u * 8192 + (4 * q4) * 128 + kperm(64 * (sw - 2) + 16 * ct + r16);
#pragma unroll
                        for (int bi = 0; bi < 4; ++bi)
#pragma unroll
                            for (int r = 0; r < 4; ++r) dst[(16 * bi + r) * 128] = (bf16)f2bf(-X[bi][ct][r]); } }
            } else LDS_BAR();
            if (has_next) {
                const LAS float* GTn = (const LAS float*)(F.lds + GP_GT + seln * GP_GT_SZ); const float gl = GTn[63];
#pragma unroll
                for (int it = 0; it < 4; ++it) { const int id = it * 256 + j, dk = id & 127, pp = id >> 7, t0 = 32 * (pp >> 2) + 4 * (pp & 3); float v[8];
#pragma unroll
                    for (int e = 0; e < 8; ++e) { const int t = t0 + (e & 3) + 4 * (e & 4); v[e] = bf2f(KB[t * 136 + dk]) * __expf(gl - GTn[t]); }
                    *(v4u*)(KDT + (size_t)un * 8192 + dk * 64 + 8 * pp) = pack8(v); }
                if (j == 0) EGL[un] = GTn[128 + 63];
            }
            LDS_BAR();
        }
#undef GP_GFETCH
    }
}

constexpr int GS_NEGW = 0, GS_QDEC = 64 * 136 * 2, GS_INTRA = GS_QDEC + 64 * 136 * 2, GS_KDT = GS_INTRA + 64 * 72 * 2, GS_OB = GS_KDT + 128 * 72 * 2, GS_LU = GS_OB + 64 * 132 * 4, GS_END = GS_LU + 64 * 132 * 4;
static_assert(GS_END <= RING_BYTES, "gdn scan LDS");
__device__ __forceinline__ bf16x8 frag2(const LAS bf16* p) { const u32x2 lo = *(const LAS u32x2*)p, hi = *(const LAS u32x2*)(p + 16); v4u w; w.x = lo.x; w.y = lo.y; w.z = hi.x; w.w = hi.y; return __builtin_bit_cast(bf16x8, w); }
__device__ __forceinline__ bf16x8 packacc(const f32x4 a, const f32x4 b) { v4u w; w.x = pg8::cvt_pk_bf16(a[0], a[1]); w.y = pg8::cvt_pk_bf16(a[2], a[3]); w.z = pg8::cvt_pk_bf16(b[0], b[1]); w.w = pg8::cvt_pk_bf16(b[2], b[3]); return __builtin_bit_cast(bf16x8, w); }
__device__ __forceinline__ void gdn_scan_unit(Frame& F, int layer, const int bh) {
    bf16* const PROJ = WSP(bf16, WS_PROJ); bf16* const MIX = WSP(bf16, WS_MIX); bf16* const NEGW = WSP(bf16, WS_NEGW); bf16* const QDEC = WSP(bf16, WS_QDEC); bf16* const KDT = WSP(bf16, WS_KDT); bf16* const INTRA = WSP(bf16, WS_INTRA); float* const UT = WSP(float, WS_UT); float* const EGL = WSP(float, WS_EGL); const float* const g_ng = INP(9);
    LAS bf16* LN = (LAS bf16*)(F.lds + GS_NEGW); LAS bf16* LQ = (LAS bf16*)(F.lds + GS_QDEC); LAS bf16* LI = (LAS bf16*)(F.lds + GS_INTRA); LAS bf16* LK = (LAS bf16*)(F.lds + GS_KDT);
    LAS float* OB = (LAS float*)(F.lds + GS_OB);
    LAS float* LU = (LAS float*)(F.lds + GS_LU);
    const int tid = F.tid, lane = F.lane, w = F.wave, r16 = lane & 15, q4 = lane >> 4;
    const float* ngain = g_ng + layer * HD;
    {
        const int b = bh / NH, h = bh % NH;
        f32x4 Sacc[8]; bf16x8 Sb[4];
#pragma unroll
        for (int i = 0; i < 8; ++i) Sacc[i] = (f32x4){0.f, 0.f, 0.f, 0.f};
#pragma unroll
        for (int i = 0; i < 4; ++i) Sb[i] = (bf16x8){0, 0, 0, 0, 0, 0, 0, 0};
        v4u st[11]; float egl;
        const int tok = tid >> 3, part = tid & 7;
#define GS_LOAD(n_) do { const size_t u_ = (size_t)bh * 64 + (n_); \
            st[0] = *(const v4u*)(NEGW + u_ * 8192 + (size_t)tid * 8); st[1] = *(const v4u*)(NEGW + u_ * 8192 + (size_t)(tid + 512) * 8); \
            st[2] = *(const v4u*)(QDEC + u_ * 8192 + (size_t)tid * 8); st[3] = *(const v4u*)(QDEC + u_ * 8192 + (size_t)(tid + 512) * 8); \
            st[4] = *(const v4u*)(INTRA + u_ * 4096 + (size_t)tid * 8); \
            st[5] = *(const v4u*)(KDT + u_ * 8192 + (size_t)tid * 8); st[6] = *(const v4u*)(KDT + u_ * 8192 + (size_t)(tid + 512) * 8); \
            _Pragma("unroll") for (int k_ = 0; k_ < 4; ++k_) st[7 + k_] = *(const v4u*)(UT + u_ * 8192 + (size_t)(tid + 512 * k_) * 4); \
            egl = EGL[u_]; } while (0)
#define GS_STORE() do { \
            *(LAS v4u*)(LN + (tid >> 4) * 136 + (tid & 15) * 8) = st[0]; *(LAS v4u*)(LN + ((tid + 512) >> 4) * 136 + (tid & 15) * 8) = st[1]; \
            *(LAS v4u*)(LQ + (tid >> 4) * 136 + (tid & 15) * 8) = st[2]; *(LAS v4u*)(LQ + ((tid + 512) >> 4) * 136 + (tid & 15) * 8) = st[3]; \
            *(LAS v4u*)(LI + (tid >> 3) * 72 + (tid & 7) * 8) = st[4]; \
            *(LAS v4u*)(LK + (tid >> 3) * 72 + (tid & 7) * 8) = st[5]; *(LAS v4u*)(LK + ((tid + 512) >> 3) * 72 + (tid & 7) * 8) = st[6]; \
            _Pragma("unroll") for (int k_ = 0; k_ < 4; ++k_) *(LAS v4u*)(LU + ((tid + 512 * k_) >> 5) * 132 + ((tid + 512 * k_) & 31) * 4) = st[7 + k_]; } while (0)
        GS_LOAD(0); GS_STORE();
        float eglc; v4u zq[2], zn[2];
        eglc = egl;
        { const bf16* zp = PROJ + (size_t)(b * SEQ + tok) * PQ + C_GZ + h * HD + 16 * part; zq[0] = *(const v4u*)zp; zq[1] = *(const v4u*)(zp + 8); }
        LDS_BAR();
        const LAS float* fU = LU + (4 * q4) * 132 + 16 * w + r16;
        const LAS bf16* fN = LN + r16 * 136 + 8 * q4; const LAS bf16* fQ = LQ + r16 * 136 + 8 * q4; const LAS bf16* fI = LI + r16 * 72 + 8 * q4; const LAS bf16* fK = LK + r16 * 72 + 8 * q4;
#define GS_RD4(buf, e0, e1, e2, e3) do { buf[0] = *(const LAS bf16x8*)(e0); buf[1] = *(const LAS bf16x8*)(e1); buf[2] = *(const LAS bf16x8*)(e2); buf[3] = *(const LAS bf16x8*)(e3); } while (0)
#define GS_SB() __builtin_amdgcn_sched_barrier(0)
#define GS_MMA(acc, a, bop) acc = __builtin_amdgcn_mfma_f32_16x16x32_bf16(a, bop, acc, 0, 0, 0)
#pragma unroll 1
        for (int n = 0; n < NCHUNK; ++n) {
            if (n + 1 < NCHUNK) { GS_LOAD(n + 1); const bf16* zp = PROJ + (size_t)(b * SEQ + (n + 1) * 64 + tok) * PQ + C_GZ + h * HD + 16 * part; zn[0] = *(const v4u*)zp; zn[1] = *(const v4u*)(zp + 8); }
            bf16x8 fa[4], fb[4]; f32x4 vacc[4], oacc[4]; bf16x8 vb[2];
            GS_RD4(fa, fQ + 0 * 16 * 136, fQ + 0 * 16 * 136 + 32, fQ + 0 * 16 * 136 + 64, fQ + 0 * 16 * 136 + 96);
            GS_RD4(fb, fQ + 1 * 16 * 136, fQ + 1 * 16 * 136 + 32, fQ + 1 * 16 * 136 + 64, fQ + 1 * 16 * 136 + 96); GS_SB();
            oacc[0] = (f32x4){0.f, 0.f, 0.f, 0.f}; GS_MMA(oacc[0], fa[0], Sb[0]); GS_MMA(oacc[0], fa[1], Sb[1]); GS_MMA(oacc[0], fa[2], Sb[2]); GS_MMA(oacc[0], fa[3], Sb[3]);
            GS_RD4(fa, fQ + 2 * 16 * 136, fQ + 2 * 16 * 136 + 32, fQ + 2 * 16 * 136 + 64, fQ + 2 * 16 * 136 + 96); GS_SB();
            oacc[1] = (f32x4){0.f, 0.f, 0.f, 0.f}; GS_MMA(oacc[1], fb[0], Sb[0]); GS_MMA(oacc[1], fb[1], Sb[1]); GS_MMA(oacc[1], fb[2], Sb[2]); GS_MMA(oacc[1], fb[3], Sb[3]);
            GS_RD4(fb, fQ + 3 * 16 * 136, fQ + 3 * 16 * 136 + 32, fQ + 3 * 16 * 136 + 64, fQ + 3 * 16 * 136 + 96); GS_SB();
            oacc[2] = (f32x4){0.f, 0.f, 0.f, 0.f}; GS_MMA(oacc[2], fa[0], Sb[0]); GS_MMA(oacc[2], fa[1], Sb[1]); GS_MMA(oacc[2], fa[2], Sb[2]); GS_MMA(oacc[2], fa[3], Sb[3]);
            GS_RD4(fa, fN + 0 * 16 * 136, fN + 0 * 16 * 136 + 32, fN + 0 * 16 * 136 + 64, fN + 0 * 16 * 136 + 96); GS_SB();
            oacc[3] = (f32x4){0.f, 0.f, 0.f, 0.f}; GS_MMA(oacc[3], fb[0], Sb[0]); GS_MMA(oacc[3], fb[1], Sb[1]); GS_MMA(oacc[3], fb[2], Sb[2]); GS_MMA(oacc[3], fb[3], Sb[3]);
            GS_RD4(fb, fN + 1 * 16 * 136, fN + 1 * 16 * 136 + 32, fN + 1 * 16 * 136 + 64, fN + 1 * 16 * 136 + 96); GS_SB();
            vacc[0] = (f32x4){fU[(0 * 16 + 0) * 132], fU[(0 * 16 + 1) * 132], fU[(0 * 16 + 2) * 132], fU[(0 * 16 + 3) * 132]}; GS_MMA(vacc[0], fa[0], Sb[0]); GS_MMA(vacc[0], fa[1], Sb[1]); GS_MMA(vacc[0], fa[2], Sb[2]); GS_MMA(vacc[0], fa[3], Sb[3]);
            GS_RD4(fa, fN + 2 * 16 * 136, fN + 2 * 16 * 136 + 32, fN + 2 * 16 * 136 + 64, fN + 2 * 16 * 136 + 96); GS_SB();
            vacc[1] = (f32x4){fU[(1 * 16 + 0) * 132], fU[(1 * 16 + 1) * 132], fU[(1 * 16 + 2) * 132], fU[(1 * 16 + 3) * 132]}; GS_MMA(vacc[1], fb[0], Sb[0]); GS_MMA(vacc[1], fb[1], Sb[1]); GS_MMA(vacc[1], fb[2], Sb[2]); GS_MMA(vacc[1], fb[3], Sb[3]);
            GS_RD4(fb, fN + 3 * 16 * 136, fN + 3 * 16 * 136 + 32, fN + 3 * 16 * 136 + 64, fN + 3 * 16 * 136 + 96); GS_SB();
            vacc[2] = (f32x4){fU[(2 * 16 + 0) * 132], fU[(2 * 16 + 1) * 132], fU[(2 * 16 + 2) * 132], fU[(2 * 16 + 3) * 132]}; GS_MMA(vacc[2], fa[0], Sb[0]); GS_MMA(vacc[2], fa[1], Sb[1]); GS_MMA(vacc[2], fa[2], Sb[2]); GS_MMA(vacc[2], fa[3], Sb[3]);
            GS_RD4(fa, fI + 0 * 16 * 72, fI + 0 * 16 * 72 + 32, fI + 1 * 16 * 72, fI + 1 * 16 * 72 + 32); GS_SB();
            vacc[3] = (f32x4){fU[(3 * 16 + 0) * 132], fU[(3 * 16 + 1) * 132], fU[(3 * 16 + 2) * 132], fU[(3 * 16 + 3) * 132]}; GS_MMA(vacc[3], fb[0], Sb[0]); GS_MMA(vacc[3], fb[1], Sb[1]); GS_MMA(vacc[3], fb[2], Sb[2]); GS_MMA(vacc[3], fb[3], Sb[3]);
            GS_RD4(fb, fI + 2 * 16 * 72, fI + 2 * 16 * 72 + 32, fI + 3 * 16 * 72, fI + 3 * 16 * 72 + 32); GS_SB();
            vb[0] = packacc(vacc[0], vacc[1]); vb[1] = packacc(vacc[2], vacc[3]);
            GS_MMA(oacc[0], fa[0], vb[0]); GS_MMA(oacc[0], fa[1], vb[1]); GS_MMA(oacc[1], fa[2], vb[0]); GS_MMA(oacc[1], fa[3], vb[1]);
            GS_RD4(fa, fK + 0 * 16 * 72, fK + 0 * 16 * 72 + 32, fK + 1 * 16 * 72, fK + 1 * 16 * 72 + 32); GS_SB();
            GS_MMA(oacc[2], fb[0], vb[0]); GS_MMA(oacc[2], fb[1], vb[1]); GS_MMA(oacc[3], fb[2], vb[0]); GS_MMA(oacc[3], fb[3], vb[1]);
            GS_RD4(fb, fK + 2 * 16 * 72, fK + 2 * 16 * 72 + 32, fK + 3 * 16 * 72, fK + 3 * 16 * 72 + 32); GS_SB();
#pragma unroll
            for (int m8 = 0; m8 < 8; ++m8) Sacc[m8] = Sacc[m8] * eglc;
            GS_MMA(Sacc[0], fa[0], vb[0]); GS_MMA(Sacc[0], fa[1], vb[1]); GS_MMA(Sacc[1], fa[2], vb[0]); GS_MMA(Sacc[1], fa[3], vb[1]);
            GS_RD4(fa, fK + 4 * 16 * 72, fK + 4 * 16 * 72 + 32, fK + 5 * 16 * 72, fK + 5 * 16 * 72 + 32); GS_SB();
            GS_MMA(Sacc[2], fb[0], vb[0]); GS_MMA(Sacc[2], fb[1], vb[1]); GS_MMA(Sacc[3], fb[2], vb[0]); GS_MMA(Sacc[3], fb[3], vb[1]);
            GS_RD4(fb, fK + 6 * 16 * 72, fK + 6 * 16 * 72 + 32, fK + 7 * 16 * 72, fK + 7 * 16 * 72 + 32); GS_SB();
            GS_MMA(Sacc[4], fa[0], vb[0]); GS_MMA(Sacc[4], fa[1], vb[1]); GS_MMA(Sacc[5], fa[2], vb[0]); GS_MMA(Sacc[5], fa[3], vb[1]); GS_SB();
            GS_MMA(Sacc[6], fb[0], vb[0]); GS_MMA(Sacc[6], fb[1], vb[1]); GS_MMA(Sacc[7], fb[2], vb[0]); GS_MMA(Sacc[7], fb[3], vb[1]);
#pragma unroll
            for (int s = 0; s < 4; ++s) Sb[s] = packacc(Sacc[2 * s], Sacc[2 * s + 1]);
#pragma unroll
            for (int mt = 0; mt < 4; ++mt)
#pragma unroll
                for (int r = 0; r < 4; ++r) OB[(16 * mt + 4 * q4 + r) * 132 + 16 * w + r16] = oacc[mt][r];
            LDS_BAR();
            {
                float o[16]; float ss = 0.f;
#pragma unroll
                for (int i = 0; i < 4; ++i) { const f32x4 v = *(const LAS f32x4*)(OB + tok * 132 + 16 * part + 4 * i); o[4 * i] = v.x; o[4 * i + 1] = v.y; o[4 * i + 2] = v.z; o[4 * i + 3] = v.w; ss += (v.x * v.x + v.y * v.y) + (v.z * v.z + v.w * v.w); }
                ss += __shfl_xor(ss, 1); ss += __shfl_xor(ss, 2); ss += __shfl_xor(ss, 4);
                const float rn = rsqrtf(ss * (1.f / HD) + EPS);
                float z[16]; { float t8[8]; unpack8(zq[0], t8);
#pragma unroll
                    for (int e = 0; e < 8; ++e) z[e] = t8[e];
                    unpack8(zq[1], t8);
#pragma unroll
                    for (int e = 0; e < 8; ++e) z[8 + e] = t8[e]; }
                float r8[8];
                bf16* dst = MIX + (size_t)(b * SEQ + n * 64 + tok) * DM + POOL_DIM + ATTN_DIM + h * HD + 16 * part;
#pragma unroll
                for (int hf = 0; hf < 2; ++hf) {
#pragma unroll
                    for (int e = 0; e < 8; ++e) { const int d = 8 * hf + e; r8[e] = o[d] * rn * ngain[16 * part + d] * silu_f(z[d]); }
                    *(v4u*)(dst + 8 * hf) = pack8(r8); }
            }
            if (n + 1 < NCHUNK) { GS_STORE(); eglc = egl; zq[0] = zn[0]; zq[1] = zn[1]; }
            LDS_BAR();
        }
#undef GS_RD4
#undef GS_SB
#undef GS_MMA
#undef GS_LOAD
#undef GS_STORE
    }
}

__device__ __forceinline__ unsigned wg_grab(Frame& F, unsigned* qc, LAS unsigned* slot) {
    if (F.tid == 0) *slot = __hip_atomic_fetch_add(qc, 1u, __ATOMIC_RELAXED, __HIP_MEMORY_SCOPE_AGENT);
    __syncthreads(); const unsigned v = *slot; __syncthreads();
    return (unsigned)__builtin_amdgcn_readfirstlane((int)v);
}
__device__ __forceinline__ void mix2_phase(Frame& F, int layer, int rep = 0) {
    constexpr unsigned NSCAN = BATCH * NH, NBLK = BATCH * NH * (SEQ / fox::QB), END = NSCAN + NBLK, NPOOL = (M / 64) * 4, ENDP = END + NPOOL;
    unsigned* qc = (unsigned*)(F.ws + WS_CTL) + CW_Q + 64 * (layer + DEPTH * rep);
    LAS unsigned* slot = (LAS unsigned*)(F.lds + MISC_OFF + 64);
    LAS int* LJ = (LAS int*)(F.lds + RING_BYTES - 3072);
    { const int* JLO = WSP(int, WS_JLO); for (int i = F.tid; i < BATCH * NH * (SEQ / fox::QB); i += NTHR) LJ[i] = JLO[i]; }
    unsigned idx = wg_grab(F, qc, slot);
#ifndef SCAN_REP
#define SCAN_REP 1
#endif
    while (idx < NSCAN) { for (int r_ = 0; r_ < SCAN_REP; ++r_) { PHASE_LOCAL(); gdn_scan_unit(F, layer, (int)idx); } idx = wg_grab(F, qc, slot); }
    if (idx < END) {
        PHASE_LOCAL();
        fox::Ctx c; c.PROJ = WSP(bf16, WS_PROJ); c.MIX = WSP(bf16, WS_MIX); c.NCK = WSP(float, WS_NCK); c.qc = qc; c.first = NSCAN; c.end = END; c.slot = slot; c.jl = LJ;
        fox::BlockRef cur = fox::item_ref(c, idx);
        fox::Seam S;
        fox::fox_prime<DM>(cur, (fox::lchar*)F.lds, S);
        for (;;) {
            unsigned ni; fox::fox_block<DM>(cur, c, (fox::lchar*)F.lds, S, ni);
            idx = ni;
            if (ni >= END) break;
            cur = fox::item_ref(c, ni);
        }
    }
    while (idx < ENDP) { PHASE_LOCAL(); pool_unit(F, layer, (int)(idx - END)); idx = wg_grab(F, qc, slot); }
}

__device__ __forceinline__ void convfix_phase(Frame& F, int layer) {
    bf16* const ACT = WSP(bf16, WS_ACT); const float* const HB = WSP(float, WS_HB); const float* const fconv_w = INP(13);
    constexpr int NPN = FFN2 / 256, NIT = (M / 256) * NPN * 2 * 16;
    const float* cw = fconv_w + (size_t)layer * 3 * FFN2;
    for (int it = F.bx * NTHR + F.tid; it < NIT; it += F.G * NTHR) {
        const int cg = it & 15, row = (it >> 4) & 1, t2 = it >> 5, pn = t2 % NPN, pm = t2 / NPN, ch = 128 * pn + 8 * cg;
        const float* cur = HB + (size_t)(pm * NPN + pn) * 1024; const float* prv = cur - (size_t)NPN * 1024; const bool has_prev = (pm & 15) != 0;
        float x0[2][8], x1[2][8], x2[2][8];
#pragma unroll
        for (int hf = 0; hf < 2; ++hf) { const int c = hf * 128 + 8 * cg;
            const f32x4 z = (f32x4){0.f, 0.f, 0.f, 0.f};
            const f32x4 a0 = *(const f32x4*)(cur + row * 256 + c), a1 = *(const f32x4*)(cur + row * 256 + c + 4);
            f32x4 b0, b1, c0, c1;
            if (row == 0) { b0 = has_prev ? *(const f32x4*)(prv + 3 * 256 + c) : z; b1 = has_prev ? *(const f32x4*)(prv + 3 * 256 + c + 4) : z; c0 = has_prev ? *(const f32x4*)(prv + 2 * 256 + c) : z; c1 = has_prev ? *(const f32x4*)(prv + 2 * 256 + c + 4) : z; }
            else { b0 = *(const f32x4*)(cur + c); b1 = *(const f32x4*)(cur + c + 4); c0 = has_prev ? *(const f32x4*)(prv + 3 * 256 + c) : z; c1 = has_prev ? *(const f32x4*)(prv + 3 * 256 + c + 4) : z; }
#pragma unroll
            for (int i = 0; i < 4; ++i) { x0[hf][i] = a0[i]; x0[hf][4 + i] = a1[i]; x1[hf][i] = b0[i]; x1[hf][4 + i] = b1[i]; x2[hf][i] = c0[i]; x2[hf][4 + i] = c1[i]; } }
        float o[8];
#pragma unroll
        for (int e = 0; e < 8; ++e) {
            const float gc = cw[ch + e] * x2[0][e] + cw[FFN2 + ch + e] * x1[0][e] + cw[2 * FFN2 + ch + e] * x0[0][e];
            const float uc = cw[FFN + ch + e] * x2[1][e] + cw[FFN2 + FFN + ch + e] * x1[1][e] + cw[2 * FFN2 + FFN + ch + e] * x0[1][e];
            o[e] = silu_f(gc) * uc; }
        *(v4u*)(ACT + (size_t)(pm * 256 + row) * FFN + ch) = pack8(o);
    }
}
#ifndef MK_PER_PHASE
#define MK_PER_PHASE 0
#endif
constexpr int WGM_IN = 4, WGM_O = 4, WGM_UP = 8, WGM_DN = 4;
constexpr int BG_QUOTA = 3;
__device__ __forceinline__ bool short_wg(int nwg, int G, int c) { const int rounds = (nwg + G - 1) / G; return (long)(rounds - 1) * G + c >= nwg; }
constexpr int PPL = 7, N_PHASES = 2 + PPL * DEPTH;
struct Args { const float* in[16]; float* out; unsigned char* ws; int ph_lo, ph_hi, fuse_fn, pad_; };
static_assert(sizeof(Args) == 16 * 8 + 8 + 8 + 16, "Args has no padding");
constexpr int WGM_FN = 2;
__global__ void __launch_bounds__(NTHR, 2) hybrid_fwd(Args args) {
    extern __shared__ __attribute__((aligned(16))) unsigned char lds_raw[];
    Frame F;
    F.lds = (lptr)lds_raw;
    F.tid = threadIdx.x; F.lane = F.tid & 63; F.wave = __builtin_amdgcn_readfirstlane(F.tid >> 6); F.G = gridDim.x; F.bx = blockIdx.x; F.z = 0;
    F.ws = args.ws; F.ka = (const float* const __attribute__((address_space(4)))*)__builtin_amdgcn_kernarg_segment_ptr();
    for (int u = F.tid; u < (LDS_BYTES - LDSCTL_OFF) / 4; u += NTHR) ((LAS unsigned*)(F.lds + LDSCTL_OFF))[u] = 0u;
    __syncthreads();
    const int lo = args.ph_lo, hi = args.ph_hi; const bool fuse_fn = args.fuse_fn != 0;
    XcdBarrier bar; bar.bar = (unsigned*)(F.ws + WS_CTL) + CW_BAR; bar.x = 0; bar.st = nullptr;
    if (hi - lo > 1) bar = xcd_barrier_post((unsigned*)(F.ws + WS_CTL) + CW_BAR, (volatile LAS unsigned*)(F.lds + MISC_OFF) + 8);
#ifndef PHM
#define PHM 0xFFFF
#endif
#define IN(k) (lo <= (k) && (k) < hi)
#define EN(b) ((PHM >> (b)) & 1)
#define SEAM(k) do { if (IN(k) && IN((k) + 1)) xcd_barrier(bar); } while (0)
#ifndef DBL
#define DBL 0
#endif
#define REP(k) for (int rep_ = 0; rep_ < (((DBL >> (k)) & 1) ? 2 : 1); ++rep_)

    float* const RS = (float*)(F.ws + WS_CTL) + CW_RS;
    constexpr float INVK = 1.f / DM;
    if (IN(0)) { PHASE_LOCAL(); p0_prologue(F); PHASE_LOCAL(); cast_rows_stat(F, INP(0), WSP(bf16, WS_XN), RS); SEAM(0); }
#pragma unroll 1
    for (int l = 0; l < DEPTH; ++l) {
        const int pb = 1 + PPL * l;
        if (IN(pb + 0)) {
            PHASE_LOCAL(); pg8::Gemm g{WSP(bf16, WS_XN), WSP(bf16, WS_WIN) + (size_t)l * NPROJ * DM, M, NPROJ, DM}; pg8::StaticOrder S; S.init(M, NPROJ, F.G, F.bx, WGM_IN);
            pg8::EpiProj E{WSP(bf16, WS_PROJ), PQ, WSP(float, WS_SMALL), PN_SMALL, RS + (size_t)(2 * l) * M, INVK, EPS, (float*)(F.ws + WS_CTL) + CW_BND + l * (BATCH * 24 * 4)};
            pg8::gemm_phase<pg8::EpiProj, pg8::StaticOrder, true, true>(F.lds, g, S, E);
            if (short_wg(S.nwg, F.G, F.bx)) { PHASE_LOCAL(); bg_convert(F, BG_QUOTA, CV_NPER); }
            SEAM(pb + 0);
        }
        if (IN(pb + 1)) { PHASE_LOCAL(); gdn_prep_phase(F, l); PHASE_LOCAL(); fox_cum_phase(F, l); SEAM(pb + 1); }
        if (IN(pb + 2)) { PHASE_LOCAL(); mix2_phase(F, l); if (l == 1) { PHASE_LOCAL(); bg_convert(F, 1 << 30, CV_W_O); } SEAM(pb + 2); }
        if (IN(pb + 3)) {
            PHASE_LOCAL(); pg8::Gemm g{WSP(bf16, WS_MIX), WSP(bf16, WS_WO) + (size_t)l * DM * DM, M, DM, DM}; pg8::StaticOrder S; S.init(M, DM, F.G, F.bx, WGM_O);
            pg8::EpiResidBfStat E{WSP(bf16, WS_XN), DM, RS + (size_t)(2 * l + 1) * M};
            pg8::gemm_phase<pg8::EpiResidBfStat, pg8::StaticOrder, true, true>(F.lds, g, S, E);
            if (l == 1) { PHASE_LOCAL(); bg_convert(F, 1 << 30, CV_W_UP); }
            SEAM(pb + 3);
        }
        if (IN(pb + 4)) {
            PHASE_LOCAL(); pg8::Gemm g{WSP(bf16, WS_XN), WSP(bf16, WS_WUP) + (size_t)l * FFN2 * DM, M, FFN2, DM}; pg8::StaticOrder S; S.init(M, FFN2, F.G, F.bx, WGM_UP);
            pg8::EpiConvGate E{WSP(bf16, WS_ACT), FFN, INP(13) + (size_t)l * 3 * FFN2, FFN, WSP(float, WS_HB), FFN2 / 256, (LAS float*)(F.lds + pg8::STAGE_BYTES), RS + (size_t)(2 * l + 1) * M, INVK, EPS};
            pg8::gemm_phase<pg8::EpiConvGate, pg8::StaticOrder, true, true>(F.lds, g, S, E);
            if (short_wg(S.nwg, F.G, F.bx)) { PHASE_LOCAL(); bg_convert(F, BG_QUOTA, CV_NPER); }
            SEAM(pb + 4);
        }
        if (IN(pb + 5)) { PHASE_LOCAL(); convfix_phase(F, l); if (l == 1) { PHASE_LOCAL(); bg_convert(F, 1 << 30, CV_NPER); } SEAM(pb + 5); }
        if (IN(pb + 6)) {
            PHASE_LOCAL(); pg8::Gemm g{WSP(bf16, WS_ACT), WSP(bf16, WS_WDN) + (size_t)l * DM * FFN, M, DM, FFN}; pg8::StaticOrder S; S.init(M, DM, F.G, F.bx, WGM_DN);
            if (l + 1 < DEPTH) { pg8::EpiResidBfStat E{WSP(bf16, WS_XN), DM, RS + (size_t)(2 * l + 2) * M};
                pg8::gemm_phase<pg8::EpiResidBfStat, pg8::StaticOrder, true, true>(F.lds, g, S, E);
                PHASE_LOCAL(); bg_convert(F, 1 << 30, CV_W_IN); }
            else if (fuse_fn) { S.init(M, DM, F.G, F.bx, WGM_FN);
                pg8::EpiFinalNorm E{WSP(bf16, WS_XN), (float*)F.ka[16 + F.z], DM, RS + (size_t)(2 * DEPTH) * M, (unsigned*)(F.ws + WS_CTL) + CW_FN, INP(15), INVK, EPS, (unsigned)(DM / 256)};
                pg8::gemm_phase<pg8::EpiFinalNorm, pg8::StaticOrder, true, true>(F.lds, g, S, E); }
            else { pg8::EpiResidBfOut E{WSP(bf16, WS_XN), WSP(float, WS_X), DM};
                pg8::gemm_phase<pg8::EpiResidBfOut, pg8::StaticOrder, true, true>(F.lds, g, S, E); }
            if (!(fuse_fn && l + 1 == DEPTH)) SEAM(pb + 6);
        }
    }
    if (IN(N_PHASES - 1) && !fuse_fn) { PHASE_LOCAL(); rms_rows_f32(F, WSP(float, WS_X), INP(15), (float*)F.ka[16 + F.z]); }
#undef IN
#undef SEAM
}

extern "C" void kernel_launch(void* const* d_in, const int* in_sizes, int n_in, void* d_out, int out_size, void* d_ws, size_t ws_size, hipStream_t stream) {
    static int grid = 0; static bool fuse_ok = false;
    if (grid == 0) {
        if (n_in != 16 || in_sizes[0] != M * DM || out_size != M * DM || ws_size < WS_END) { fprintf(stderr, "kernel_launch: shape/workspace mismatch (n_in %d, in0 %d, out %d, ws %zu, need %zu); nothing launched\n", n_in, n_in > 0 ? in_sizes[0] : -1, out_size, ws_size, (size_t)WS_END); grid = -1; return; }
        int dev = 0, cus = 0, per_cu = 0;
        if (hipGetDevice(&dev) != hipSuccess || hipDeviceGetAttribute(&cus, hipDeviceAttributeMultiprocessorCount, dev) != hipSuccess) { fprintf(stderr, "kernel_launch: device query failed\n"); grid = -1; return; }
        if (hipFuncSetAttribute((const void*)hybrid_fwd, hipFuncAttributeMaxDynamicSharedMemorySize, LDS_BYTES) != hipSuccess) { fprintf(stderr, "kernel_launch: hipFuncSetAttribute failed\n"); grid = -1; return; }
        if (hipOccupancyMaxActiveBlocksPerMultiprocessor(&per_cu, (const void*)hybrid_fwd, NTHR, LDS_BYTES) != hipSuccess || per_cu < 1) fprintf(stderr, "kernel_launch: note: occupancy query reports %d workgroups per CU\n", per_cu);
        (void)hipGetLastError();
        grid = cus;
        {
            static int round_of[(M / 256) * (DM / 256)]; bool ok = true; int seen = 0;
            for (int c = 0; c < grid; ++c) { pg8::StaticOrder S; S.init(M, DM, grid, c, WGM_FN); pg8::Unit u; for (int i = 0; S.next(i, u); ++i) { round_of[u.pm * (DM / 256) + u.pn] = i; ++seen; } }
            for (int pm = 0; pm < M / 256 && ok; ++pm) for (int pn = 1; pn < DM / 256; ++pn) if (round_of[pm * (DM / 256) + pn] != round_of[pm * (DM / 256)]) { ok = false; break; }
            fuse_ok = ok && seen == (M / 256) * (DM / 256);
        }
    }
    if (grid < 0) return;
    if (hipMemsetAsync((char*)d_ws + WS_CTL, 0, CTL_ZERO_BYTES, stream) != hipSuccess) { fprintf(stderr, "kernel_launch: memset failed\n"); return; }
    Args a{};
    for (int i = 0; i < 16; ++i) a.in[i] = (const float*)d_in[i];
    a.out = (float*)d_out; a.ws = (unsigned char*)d_ws; a.fuse_fn = (fuse_ok && !MK_PER_PHASE) ? 1 : 0;
#if MK_PER_PHASE
    for (int p = 0; p < N_PHASES; ++p) { a.ph_lo = p; a.ph_hi = p + 1; hipLaunchKernelGGL(hybrid_fwd, dim3(grid), dim3(NTHR), LDS_BYTES, stream, a); }
#else
    a.ph_lo = 0; a.ph_hi = N_PHASES; hipLaunchKernelGGL(hybrid_fwd, dim3(grid), dim3(NTHR), LDS_BYTES, stream, a);
#endif
    const hipError_t le = hipPeekAtLastError();
    if (le != hipSuccess) fprintf(stderr, "kernel_launch: launch failed: %s\n", hipGetErrorName(le));
}
```
